# Optimizing an MI355X kernel written in HIP

```python
import math
import jax, jax.numpy as jnp
from jax import lax
import numpy as np

D_MODEL = 1024
BATCH = 2
SEQ = 8192
DEPTH = 2
DEC_BATCH = 16
DEC_SEQ = 64
PAST_LEN = 2048

CHUNK = 64
D_MIX = D_MODEL
S5_WIDTH = D_MIX // 2
S5_CH = 16
S5_GROUPS = S5_WIDTH // S5_CH
S5_STATE = 64
POOL_WIDTH = D_MIX - S5_WIDTH
POOL_WINDOWS = (2, 4, 8, 16)
POOL_GROUPS = len(POOL_WINDOWS)
POOL_CH = POOL_WIDTH // POOL_GROUPS
POOL_HIST = max(POOL_WINDOWS) - 1
D_FF = 2816
EPS = 1e-6
DT_MIN = 1e-3
DT_MAX = 1e-1

kernel_name = "s5_pool_hybrid_streaming_step"


def rms_norm(x, g):
    xf = x.astype(jnp.float32)
    y = xf * lax.rsqrt(jnp.mean(xf * xf, axis=-1, keepdims=True) + EPS)
    return (y * g.astype(jnp.float32)).astype(x.dtype)


def swiglu(x, w_gate, w_up, w_down):
    return (jax.nn.silu(x @ w_gate) * (x @ w_up)) @ w_down


def complex_combine(e1, e2):
    a1r, a1i, b1r, b1i = e1
    a2r, a2i, b2r, b2i = e2
    ar = a1r * a2r - a1i * a2i
    ai = a1r * a2i + a1i * a2r
    br = a2r * b1r - a2i * b1i + b2r
    bi = a2r * b1i + a2i * b1r + b2i
    return (ar, ai, br, bi)


def s5_mixer(u, lam_re, lam_im, log_dt, b_re, b_im, c_re, c_im, d, w_glu, b_glu, h0_re, h0_im):
    bsz, length, _ = u.shape
    uf = u.astype(jnp.float32).reshape(bsz, length, S5_GROUPS, S5_CH)
    dt = jnp.exp(log_dt.astype(jnp.float32))[:, None]
    lr = lam_re.astype(jnp.float32)
    li = lam_im.astype(jnp.float32)
    mag = jnp.exp(lr * dt)
    ar = mag * jnp.cos(li * dt)
    ai = mag * jnp.sin(li * dt)
    den = lr * lr + li * li
    nr = ar - 1.0
    ni = ai
    kr = (nr * lr + ni * li) / den
    ki = (ni * lr - nr * li) / den
    br = b_re.astype(jnp.float32)
    bi = b_im.astype(jnp.float32)
    bbar_r = kr[..., None] * br - ki[..., None] * bi
    bbar_i = kr[..., None] * bi + ki[..., None] * br
    xr = jnp.einsum('blgh,gph->blgp', uf, bbar_r)
    xi = jnp.einsum('blgh,gph->blgp', uf, bbar_i)
    if h0_re is not None:
        h0r = h0_re.astype(jnp.float32)
        h0i = h0_im.astype(jnp.float32)
        xr = xr.at[:, 0].add(ar * h0r - ai * h0i)
        xi = xi.at[:, 0].add(ar * h0i + ai * h0r)
    a_r = jnp.broadcast_to(ar, (1, length, S5_GROUPS, S5_STATE))
    a_i = jnp.broadcast_to(ai, (1, length, S5_GROUPS, S5_STATE))
    _, _, hr, hi = lax.associative_scan(complex_combine, (a_r, a_i, xr, xi), axis=1)
    y = (jnp.einsum('blgp,ghp->blgh', hr, c_re.astype(jnp.float32))
         - jnp.einsum('blgp,ghp->blgh', hi, c_im.astype(jnp.float32))
         + d.astype(jnp.float32) * uf)
    g = jax.nn.gelu(y.reshape(bsz, length, S5_WIDTH))
    out = g * jax.nn.sigmoid(g @ w_glu.astype(jnp.float32) + b_glu.astype(jnp.float32))
    return out.astype(u.dtype), hr[:, -1], hi[:, -1]


def pool_mixer(v, w_pool, scale, hist):
    bsz, length, _ = v.shape
    vf = v.astype(jnp.float32)
    if hist is None:
        ext = jnp.pad(vf, ((0, 0), (POOL_HIST, 0), (0, 0)))
    else:
        ext = jnp.concatenate([hist.astype(jnp.float32), vf], axis=1)
    cs = jnp.cumsum(jnp.pad(ext, ((0, 0), (1, 0), (0, 0))), axis=1)
    t = jnp.arange(length, dtype=jnp.float32)[None, :, None]
    outs = []
    for gi, w in enumerate(POOL_WINDOWS):
        sl = slice(gi * POOL_CH, (gi + 1) * POOL_CH)
        win = (cs[:, POOL_HIST + 1:POOL_HIST + 1 + length, sl]
               - cs[:, POOL_HIST + 1 - w:POOL_HIST + 1 - w + length, sl])
        cnt = jnp.minimum(t + 1.0, float(w)) if hist is None else float(w)
        outs.append((win / cnt - vf[..., sl]) @ w_pool[gi].astype(jnp.float32))
    out = jnp.concatenate(outs, axis=-1) * scale.astype(jnp.float32)
    tail = ext[:, -POOL_HIST:]
    return out.astype(v.dtype), tail.astype(v.dtype)


def layer(x, lp, h0_re, h0_im, hist):
    x = x + 0.5 * swiglu(rms_norm(x, lp['n1']), lp['f1g'], lp['f1u'], lp['f1d'])
    u = rms_norm(x, lp['nm']) @ lp['w_in']
    s5_out, hr, hi = s5_mixer(u[..., :S5_WIDTH], lp['lre'], lp['lim'], lp['ldt'], lp['bre'], lp['bim'],
                              lp['cre'], lp['cim'], lp['d'], lp['wglu'], lp['bglu'], h0_re, h0_im)
    pool_out, tail = pool_mixer(u[..., S5_WIDTH:], lp['wpool'], lp['pscale'], hist)
    m = jnp.concatenate([rms_norm(s5_out, lp['gs5']), rms_norm(pool_out, lp['gpool'])], axis=-1)
    x = x + m @ lp['w_out']
    x = x + 0.5 * swiglu(rms_norm(x, lp['n2']), lp['f2g'], lp['f2u'], lp['f2d'])
    return x, hr.astype(x.dtype), hi.astype(x.dtype), tail


def setup_inputs(seed: int = 0) -> dict:
    key = jax.random.key(seed)
    ks = iter(jax.random.split(key, 40))
    f32 = jnp.float32

    def nrm(shape, scale):
        return jax.random.normal(next(ks), shape, f32) * scale

    def gain(shape):
        return 1.0 + nrm(shape, 0.02)

    n = jnp.arange(S5_STATE, dtype=f32)
    lam_re = -0.5 + nrm((DEPTH, S5_GROUPS, S5_STATE), 0.01)
    lam_im = math.pi * n[None, None, :] + nrm((DEPTH, S5_GROUPS, S5_STATE), 0.01)
    log_dt = jax.random.uniform(next(ks), (DEPTH, S5_GROUPS), f32, math.log(DT_MIN), math.log(DT_MAX))

    return {
        'x_prompt': nrm((BATCH, SEQ, D_MODEL), 1.0),
        'x_sample': nrm((DEC_BATCH, DEC_SEQ, D_MODEL), 1.0),
        'state_s5_re': nrm((DEPTH, DEC_BATCH, S5_GROUPS, S5_STATE), 0.3),
        'state_s5_im': nrm((DEPTH, DEC_BATCH, S5_GROUPS, S5_STATE), 0.3),
        'state_pool': nrm((DEPTH, DEC_BATCH, POOL_HIST, POOL_WIDTH), 1.0),
        'norm_ffn1': gain((DEPTH, D_MODEL)),
        'ffn1_w_gate': nrm((DEPTH, D_MODEL, D_FF), D_MODEL ** -0.5),
        'ffn1_w_up': nrm((DEPTH, D_MODEL, D_FF), D_MODEL ** -0.5),
        'ffn1_w_down': nrm((DEPTH, D_FF, D_MODEL), D_FF ** -0.5),
        'norm_mix': gain((DEPTH, D_MODEL)),
        'w_in': nrm((DEPTH, D_MODEL, D_MIX), D_MODEL ** -0.5),
        's5_lambda_re': lam_re,
        's5_lambda_im': lam_im,
        's5_log_dt': log_dt,
        's5_b_re': nrm((DEPTH, S5_GROUPS, S5_STATE, S5_CH), (2 * S5_CH) ** -0.5),
        's5_b_im': nrm((DEPTH, S5_GROUPS, S5_STATE, S5_CH), (2 * S5_CH) ** -0.5),
        's5_c_re': nrm((DEPTH, S5_GROUPS, S5_CH, S5_STATE), (2 * S5_STATE) ** -0.5 * 4.0),
        's5_c_im': nrm((DEPTH, S5_GROUPS, S5_CH, S5_STATE), (2 * S5_STATE) ** -0.5 * 4.0),
        's5_d': nrm((DEPTH, S5_GROUPS, S5_CH), 1.0),
        's5_w_glu': nrm((DEPTH, S5_WIDTH, S5_WIDTH), S5_WIDTH ** -0.5),
        's5_b_glu': nrm((DEPTH, S5_WIDTH), 0.02),
        'pool_w': nrm((DEPTH, POOL_GROUPS, POOL_CH, POOL_CH), POOL_CH ** -0.5),
        'pool_scale': gain((DEPTH, POOL_WIDTH)),
        'gn_s5': gain((DEPTH, S5_WIDTH)),
        'gn_pool': gain((DEPTH, POOL_WIDTH)),
        'w_out': nrm((DEPTH, D_MIX, D_MODEL), D_MIX ** -0.5),
        'norm_ffn2': gain((DEPTH, D_MODEL)),
        'ffn2_w_gate': nrm((DEPTH, D_MODEL, D_FF), D_MODEL ** -0.5),
        'ffn2_w_up': nrm((DEPTH, D_MODEL, D_FF), D_MODEL ** -0.5),
        'ffn2_w_down': nrm((DEPTH, D_FF, D_MODEL), D_FF ** -0.5),
        'norm_final': gain((D_MODEL,)),
    }


def reference(x_prompt, x_sample, state_s5_re, state_s5_im, state_pool,
              norm_ffn1, ffn1_w_gate, ffn1_w_up, ffn1_w_down,
              norm_mix, w_in, s5_lambda_re, s5_lambda_im, s5_log_dt,
              s5_b_re, s5_b_im, s5_c_re, s5_c_im, s5_d, s5_w_glu, s5_b_glu,
              pool_w, pool_scale, gn_s5, gn_pool, w_out,
              norm_ffn2, ffn2_w_gate, ffn2_w_up, ffn2_w_down, norm_final):
    xp = x_prompt
    xs = x_sample
    p_re, p_im, p_pool = [], [], []
    s_re, s_im, s_pool = [], [], []
    for l in range(DEPTH):
        lp = {
            'n1': norm_ffn1[l], 'f1g': ffn1_w_gate[l], 'f1u': ffn1_w_up[l], 'f1d': ffn1_w_down[l],
            'nm': norm_mix[l], 'w_in': w_in[l],
            'lre': s5_lambda_re[l], 'lim': s5_lambda_im[l], 'ldt': s5_log_dt[l],
            'bre': s5_b_re[l], 'bim': s5_b_im[l], 'cre': s5_c_re[l], 'cim': s5_c_im[l],
            'd': s5_d[l], 'wglu': s5_w_glu[l], 'bglu': s5_b_glu[l],
            'wpool': pool_w[l], 'pscale': pool_scale[l],
            'gs5': gn_s5[l], 'gpool': gn_pool[l], 'w_out': w_out[l],
            'n2': norm_ffn2[l], 'f2g': ffn2_w_gate[l], 'f2u': ffn2_w_up[l], 'f2d': ffn2_w_down[l],
        }
        xp, hr, hi, tail = layer(xp, lp, None, None, None)
        p_re.append(hr)
        p_im.append(hi)
        p_pool.append(tail)
        xs, hr, hi, tail = layer(xs, lp, state_s5_re[l], state_s5_im[l], state_pool[l])
        s_re.append(hr)
        s_im.append(hi)
        s_pool.append(tail)
    y_prompt = rms_norm(xp, norm_final)
    y_sample = rms_norm(xs, norm_final)
    return (y_prompt, y_sample,
            jnp.stack(p_re), jnp.stack(p_im), jnp.stack(p_pool),
            jnp.stack(s_re), jnp.stack(s_im), jnp.stack(s_pool))
```

```cpp
#include <hip/hip_runtime.h>
#include <cstdio>
#include <cstdint>
#include <cmath>
#define DEFER_L1 1000
#define XL_SEAMS 1
#define I8U 1
namespace pg8 {
__device__ __forceinline__ int fresh_lane() { int l; asm volatile("v_mbcnt_lo_u32_b32 %0, -1, 0\n\tv_mbcnt_hi_u32_b32 %0, -1, %0" : "=v"(l)); return l; }
__device__ __forceinline__ float shfl_xor_l(float v, int mask, int lane) { return __builtin_bit_cast(float, __builtin_amdgcn_ds_bpermute((lane ^ mask) << 2, __builtin_bit_cast(int, v))); }
#define PG8_LAS __attribute__((address_space(3)))
typedef unsigned short bf16_t;
typedef short bf16x8 __attribute__((ext_vector_type(8)));
typedef float f32x4 __attribute__((ext_vector_type(4)));
typedef int i32x4 __attribute__((ext_vector_type(4)));
typedef unsigned u32x4 __attribute__((ext_vector_type(4)));
typedef unsigned u32x2 __attribute__((ext_vector_type(2)));
constexpr int BM = 256, BK = 64, HALF = 128, HTB = HALF * BK * 2  , STAGE_BYTES = 8 * HTB, NXCD = 8, WGM = 4;

__host__ __device__ __forceinline__ int lds_byte(int r, int c) { const int st = (r >> 4) * 2 + (c >> 5), rr = r & 15, cc = c & 31, ob = rr * 64 + cc * 2; return st * 1024 + (ob ^ (((ob >> 9) & 1) << 5)); }
__host__ __device__ __forceinline__ void stage_rc(int b, int& R, int& C) { const int st = b / 1024, sb = b % 1024, swz = sb ^ (((sb >> 9) & 1) << 5); R = (st >> 1) * 16 + swz / 64; C = (st & 1) * 32 + (swz % 64) / 2; }
__host__ __device__ __forceinline__ int perm32(int rho) { const int n = rho >> 4, i = rho & 15; return 8 * (i >> 2) + 4 * n + (i & 3); }

struct Unit { int pm, pn, nt; };
struct Gemm { const bf16_t* A; const bf16_t* Bt; int K, lda, ldb, a_pn_off, xrow0; };

struct StaticOrder {
    int nM, nN, nwg, G, c, ntf;
    __host__ __device__ __forceinline__ void init(int M, int N, int K, int G_, int c_) { nM = M / BM; nN = N / BM; nwg = nM * nN; G = G_; c = c_; ntf = K / BK; }
    __host__ __device__ __forceinline__ Unit next(int i) const {
        Unit u; u.pm = 0; u.pn = 0; u.nt = 0;
        const long L = (long)i * G + c; if (c < 0 || L >= nwg) return u;
        int wgid = (int)L; { const int q = nwg / NXCD, r = nwg % NXCD, xcd = wgid % NXCD, off = wgid / NXCD; wgid = (xcd < r ? xcd * (q + 1) : r * (q + 1) + (xcd - r) * q) + off; }
        const int nig = WGM * nN, gid = wgid / nig, fm = gid * WGM, gsz = (nM - fm) < WGM ? (nM - fm) : WGM;
        u.pm = fm + ((wgid % nig) % gsz); u.pn = (wgid % nig) / gsz; u.nt = ntf; return u;
    }
};

constexpr int RS_ROWS = 272, RS_STRIDE = RS_ROWS + 256;
template <int NP> __device__ __forceinline__ void rs_table(PG8_LAS float* rt, int row0, int xrow0, int tid);
template <bool RIDER, class Epi, class Sched>
__device__ __forceinline__ void gemm_phase(PG8_LAS unsigned char* lds, const int tid, const int wid, const Gemm g, const Sched& S, const Epi& E) {
    const int lane = tid & 63, wr = wid >> 2, wc = wid & 3, fr = lane & 15, fq = lane >> 4;
    unsigned voffA[2], voffB[2];
#pragma unroll
    for (int i = 0; i < 2; ++i) { int R, C; stage_rc(tid * 16 + i * 8192, R, C); const int Rb = Epi::PERM ? ((R & ~31) + perm32(R & 31)) : R;
        voffA[i] = (unsigned)(R * g.lda + C) * 2u; voffB[i] = (unsigned)(Rb * g.ldb + C) * 2u; }
    const size_t kstep = (size_t)(BK * 2);
    const size_t hstepA = (size_t)HALF * g.lda * 2, hstepB = (size_t)HALF * g.ldb * 2;
    const size_t tstepA = 2 * hstepA, tstepB = 2 * hstepB;
    const size_t pnoffA = (size_t)g.a_pn_off * 2;
    const unsigned ldsw = (unsigned)wid * 1024u;
    const int aoff = lds_byte(wr * 64 + fr, fq * 8), boff = lds_byte(wc * 32 + fr, fq * 8);
    unsigned voffX = 0; const int xoff = lds_byte(fr, fq * 8);
    if (RIDER) { int R, C; stage_rc((wid * 16 + (lane & 15)) * 16, R, C); voffX = (unsigned)(R * g.lda + C) * 2u; }
    static_assert(!RIDER || Epi::PERM, "rider phases use the permuted column order");
    PG8_LAS float* rtab = (PG8_LAS float*)(lds + STAGE_BYTES + 4096 + 1024);
#define PG8_SA(b, h) (((b) * 2 + (h)) * HTB)
#define PG8_SB(b, h) ((4 + (b) * 2 + (h)) * HTB)
#define PG8_STAGE_(bufoff, gbase, voff, aux) do { _Pragma("unroll") for (int _i = 0; _i < 2; ++_i) \
        __builtin_amdgcn_global_load_lds((const unsigned*)((const char*)(gbase) + (voff)[_i]), (PG8_LAS unsigned*)(lds + (bufoff) + ldsw + _i * 8192), 16, 0, aux); } while (0)
#define PG8_STAGE(bufoff, gbase, voff) PG8_STAGE_(bufoff, gbase, voff, 0)
#define PG8_STAGEA(bufoff, gbase, voff) PG8_STAGE_(bufoff, gbase, voff, Epi::A_AUX)
#define PG8_LDA(dst, b, h) do { _Pragma("unroll") for (int m = 0; m < 4; ++m) _Pragma("unroll") for (int k = 0; k < 2; ++k) dst[m][k] = *(const PG8_LAS bf16x8*)(lds + PG8_SA(b, h) + aoff + m * 2048 + k * 1024); } while (0)
#define PG8_LDB(dst, b, h) do { _Pragma("unroll") for (int n = 0; n < 2; ++n) _Pragma("unroll") for (int k = 0; k < 2; ++k) dst[n][k] = *(const PG8_LAS bf16x8*)(lds + PG8_SB(b, h) + boff + n * 2048 + k * 1024); } while (0)
#define PG8_MMA(ai, bj, At, Bt) do { __builtin_amdgcn_s_setprio(1); _Pragma("unroll") for (int m = 0; m < 4; ++m) _Pragma("unroll") for (int n = 0; n < 2; ++n) _Pragma("unroll") for (int k = 0; k < 2; ++k) \
        { if constexpr (Epi::I8) acc[ai][bj][m][n] = __builtin_bit_cast(f32x4, __builtin_amdgcn_mfma_i32_16x16x64_i8(__builtin_bit_cast(i32x4, Bt[n][k]), __builtin_bit_cast(i32x4, At[m][k]), __builtin_bit_cast(i32x4, acc[ai][bj][m][n]), 0, 0, 0)); \
          else acc[ai][bj][m][n] = __builtin_amdgcn_mfma_f32_16x16x32_bf16(Bt[n][k], At[m][k], acc[ai][bj][m][n], 0, 0, 0); } __builtin_amdgcn_s_setprio(0); } while (0)
#define PG8_STAGEX(b, gbase) do { if (RIDER) { if (lane < 16) __builtin_amdgcn_global_load_lds((const unsigned*)((const char*)(gbase) + voffX), (PG8_LAS unsigned*)(lds + STAGE_BYTES + (b) * 2048 + wid * 256), 16, 0, 0); } } while (0)
#define PG8_LDX(b) do { if (RIDER) { _Pragma("unroll") for (int k = 0; k < 2; ++k) Ax[k] = *(const PG8_LAS bf16x8*)(lds + STAGE_BYTES + (b) * 2048 + xoff + k * 1024); } } while (0)
#define PG8_MMAX() do { if (RIDER) { __builtin_amdgcn_s_setprio(1); if (wr == 0) { _Pragma("unroll") for (int n = 0; n < 2; ++n) _Pragma("unroll") for (int k = 0; k < 2; ++k) accx[n] = __builtin_amdgcn_mfma_f32_16x16x32_bf16(B0[n][k], Ax[k], accx[n], 0, 0, 0); } \
        else { _Pragma("unroll") for (int n = 0; n < 2; ++n) _Pragma("unroll") for (int k = 0; k < 2; ++k) accx[n] = __builtin_amdgcn_mfma_f32_16x16x32_bf16(B1[n][k], Ax[k], accx[n], 0, 0, 0); } __builtin_amdgcn_s_setprio(0); } } while (0)
#define PG8_WV(n, nr) do { if (RIDER) PG8_WAIT_V(nr); else PG8_WAIT_V(n); } while (0)
#define PG8_WAIT_V(n) asm volatile("s_waitcnt vmcnt(" #n ")" ::: "memory")
#define PG8_WAIT_L(n) asm volatile("s_waitcnt lgkmcnt(" #n ")" ::: "memory")
#define PG8_BAR __builtin_amdgcn_s_barrier()
#define PG8_SCHED __builtin_amdgcn_sched_barrier(0)
    Unit cur = S.next(0), nxt; int ui = 0;
    if (cur.nt == 0) return;
    f32x4 acc[2][2][4][2];
#pragma unroll
    for (int a = 0; a < 2; ++a)
#pragma unroll
        for (int b = 0; b < 2; ++b)
#pragma unroll
            for (int m = 0; m < 4; ++m)
#pragma unroll
                for (int n = 0; n < 2; ++n) acc[a][b][m][n] = (f32x4){0.f, 0.f, 0.f, 0.f};
    bf16x8 At[4][2], B0[2][2], B1[2][2], Ax[2]; f32x4 accx[2] = {{0.f, 0.f, 0.f, 0.f}, {0.f, 0.f, 0.f, 0.f}};
    const size_t xstep = (size_t)16 * g.lda * 2;
    const char* cA = (const char*)g.A + (size_t)cur.pm * tstepA + (size_t)cur.pn * pnoffA; const char* cB = (const char*)g.Bt + (size_t)cur.pn * tstepB;
    const char* cX = (const char*)g.A + (size_t)g.xrow0 * g.lda * 2 + (size_t)cur.pm * xstep + (size_t)cur.pn * pnoffA;
    PG8_STAGE(PG8_SB(0, 0), cB, voffB); PG8_STAGE(PG8_SB(0, 1), cB + hstepB, voffB); PG8_STAGEA(PG8_SA(0, 0), cA, voffA); PG8_STAGEX(0, cX); PG8_STAGEA(PG8_SA(0, 1), cA + hstepA, voffA);
    if constexpr (Epi::RS_NP != 0) {
        for (int i = 0; i < 8; ++i) { const Unit uu = S.next(i); if (uu.nt == 0) break; E.table(rtab + i * RS_STRIDE, uu.pm * BM, RIDER ? g.xrow0 + 16 * uu.pm : -1, tid, uu.pn); }
    }
    if (wr == 1) PG8_BAR;
    PG8_WAIT_V(2); PG8_BAR;
    PG8_STAGE(PG8_SB(1, 0), cB + kstep, voffB); PG8_STAGEA(PG8_SA(1, 0), cA + kstep, voffA); PG8_STAGE(PG8_SB(1, 1), cB + hstepB + kstep, voffB); PG8_STAGEX(1, cX + kstep);
    PG8_WV(6, 7); PG8_BAR;
    for (;;) {
        nxt = S.next(ui + 1); const bool has_next = nxt.nt != 0;
        const char* nA = has_next ? (const char*)g.A + (size_t)nxt.pm * tstepA + (size_t)nxt.pn * pnoffA : cA; const char* nB = has_next ? (const char*)g.Bt + (size_t)nxt.pn * tstepB : cB;
        const char* nX = has_next ? (const char*)g.A + (size_t)g.xrow0 * g.lda * 2 + (size_t)nxt.pm * xstep + (size_t)nxt.pn * pnoffA : cX;
        const int nt = cur.nt;
        for (int t = 0; t < nt; t += 2) {
            const bool last = (t == nt - 2);
            const char* a1 = cA + (size_t)(t + 1) * kstep;
            const char* a2 = last ? nA : cA + (size_t)(t + 2) * kstep; const char* b2 = last ? nB : cB + (size_t)(t + 2) * kstep;
            const char* a3 = a2 + kstep; const char* b3 = b2 + kstep;
            const char* x2 = last ? nX : cX + (size_t)(t + 2) * kstep; const char* x3 = x2 + kstep;
            if constexpr (Epi::MID != 0) { if (t == Epi::MID) { const int ln_ = fresh_lane(); E.mid(acc, accx, cur, wr, ln_ & 15, ln_ >> 4, ln_); } }
            PG8_LDB(B0, 0, 0); PG8_LDB(B1, 0, 1); PG8_SCHED; PG8_LDA(At, 0, 0); PG8_LDX(0); PG8_STAGEA(PG8_SA(1, 1), a1 + hstepA, voffA);
            PG8_WV(8, 9); PG8_WAIT_L(0); PG8_BAR; PG8_MMA(0, 0, At, B0); PG8_MMA(0, 1, At, B1); PG8_MMAX(); PG8_BAR; PG8_SCHED;
            PG8_LDA(At, 0, 1); PG8_STAGE(PG8_SB(0, 0), b2, voffB); PG8_STAGE(PG8_SB(0, 1), b2 + hstepB, voffB); PG8_STAGEA(PG8_SA(0, 0), a2, voffA); PG8_STAGEX(0, x2);
            PG8_WV(8, 9); PG8_WAIT_L(0); PG8_BAR; PG8_MMA(1, 0, At, B0); PG8_MMA(1, 1, At, B1); PG8_BAR; PG8_SCHED;
            PG8_LDB(B0, 1, 0); PG8_LDB(B1, 1, 1); PG8_SCHED; PG8_LDA(At, 1, 0); PG8_LDX(1); PG8_STAGEA(PG8_SA(0, 1), a2 + hstepA, voffA);
            PG8_WV(8, 9); PG8_WAIT_L(0); PG8_BAR; PG8_MMA(0, 0, At, B0); PG8_MMA(0, 1, At, B1); PG8_MMAX(); PG8_BAR; PG8_SCHED;
            PG8_LDA(At, 1, 1); PG8_STAGE(PG8_SB(1, 0), b3, voffB); PG8_STAGE(PG8_SB(1, 1), b3 + hstepB, voffB); PG8_STAGEA(PG8_SA(1, 0), a3, voffA); PG8_STAGEX(1, x3);
            PG8_WV(8, 9); PG8_WAIT_L(0); PG8_BAR; PG8_MMA(1, 0, At, B0); PG8_MMA(1, 1, At, B1); PG8_BAR; PG8_SCHED;
        }
        if (wr == 0) PG8_BAR;
        { const int ln_ = fresh_lane(); E(acc, accx, cur, wr, wc, ln_ & 15, ln_ >> 4, ln_, rtab + (ui & 7) * RS_STRIDE); }
        if (!has_next) break;
#pragma unroll
        for (int a = 0; a < 2; ++a)
#pragma unroll
            for (int b = 0; b < 2; ++b)
#pragma unroll
                for (int m = 0; m < 4; ++m)
#pragma unroll
                    for (int n = 0; n < 2; ++n) acc[a][b][m][n] = (f32x4){0.f, 0.f, 0.f, 0.f};
        accx[0] = (f32x4){0.f, 0.f, 0.f, 0.f}; accx[1] = (f32x4){0.f, 0.f, 0.f, 0.f};
        cur = nxt; cA = nA; cB = nB; cX = nX; ++ui;
        if (wr == 1) PG8_BAR;
    }
    PG8_WAIT_V(0);
    PG8_BAR;
#undef PG8_SA
#undef PG8_SB
#undef PG8_STAGE
#undef PG8_STAGE_
#undef PG8_STAGEA
#undef PG8_LDA
#undef PG8_LDB
#undef PG8_MMA
#undef PG8_STAGEX
#undef PG8_LDX
#undef PG8_MMAX
#undef PG8_WV
#undef PG8_WAIT_V
#undef PG8_WAIT_L
#undef PG8_BAR
#undef PG8_SCHED
}
}
constexpr int D = 1024, FF = 2816, DEPTH = 2;
constexpr int PB = 2, PL = 8192, SB = 16, SL = 64;
constexpr int MP = PB * PL, MS = SB * SL, M = MP + MS;
constexpr int G = 32, P = 64, H = 16, SW = 512, PW = 512, HIST = 15;
constexpr int NSC = M / 32;
constexpr float EPS = 1e-6f;

constexpr size_t MiB = 1u << 20;
constexpr size_t WS_CTL = 0, CTL_ZERO_BYTES = 192 * 1024;
constexpr size_t WS_TAB = 1 * MiB;
constexpr size_t TAB_A = 0, TAB_A32 = 32 * 1024, TAB_BB = 64 * 1024, TAB_C = TAB_BB + 256 * 1024;
constexpr size_t WS_W = 2 * MiB, W_LAYER = 38 * MiB;
constexpr size_t W_UP1 = 0, W_DN1 = 11 * MiB, W_UP2 = W_DN1 + 11 * MiB / 2, W_DN2 = W_UP2 + 11 * MiB, W_IN = W_DN2 + 11 * MiB / 2, W_OUT = W_IN + 2 * MiB, W_GLU = W_OUT + 2 * MiB, W_POOL = W_GLU + MiB / 2;
static_assert(W_POOL + MiB / 4 <= W_LAYER, "weight map");
constexpr size_t WS_XB = WS_W + 2 * W_LAYER;
constexpr size_t WS_SSQ = WS_XB + 34 * MiB;
constexpr size_t WS_SSQS = WS_SSQ + (size_t)M * 32 * 4, WS_SSQP = WS_SSQS + (size_t)M * 16 * 4;
constexpr size_t WS_E = WS_SSQ + 5 * MiB;
constexpr size_t E_BYTES = (size_t)NSC * G * P * 4;
constexpr size_t WS_PRE = WS_E + 17 * MiB;
constexpr size_t WS_H = WS_PRE + 17 * MiB;
constexpr size_t WS_U = WS_H, WS_GB = WS_H + 34 * MiB, WS_MC = WS_H + 51 * MiB;
constexpr size_t WS_END = WS_H + (size_t)M * FF * 2;
static_assert(WS_END <= 256 * MiB && WS_MC + 34 * MiB <= WS_END, "workspace map");
#if defined(I8U)
constexpr bool I8U_ON = true;
#else
constexpr bool I8U_ON = false;
#endif
constexpr size_t WS_XQ = WS_PRE, WS_QSA = WS_SSQ + 4 * MiB + MiB / 2, WS_QSB = WS_QSA + 128 * 1024;
static_assert(WS_SSQP + (size_t)M * 16 * 4 <= WS_QSA && WS_QSB + (size_t)M * 4 <= WS_E, "QS map");
constexpr size_t WS_CMAX = 64 * 1024;
constexpr float QCLIP = 6.0f, QCLIP0 = 5.0f;
struct Args { const float* in[31]; float* out; unsigned char* ws; int ph_lo, ph_hi; };
typedef const __attribute__((address_space(4))) Args* KArgsPtr;
__device__ __forceinline__ const Args& kargs() { KArgsPtr kp = (KArgsPtr)__builtin_amdgcn_kernarg_segment_ptr(); asm volatile("" : "+s"(kp)); return *(const Args*)kp; }
#ifndef A_AUX_RES
#define A_AUX_RES 0
#endif
namespace pg8 {
__device__ __forceinline__ unsigned cvt_pk_bf16(float lo, float hi) { unsigned r; asm volatile("v_cvt_pk_bf16_f32 %0, %1, %2" : "=v"(r) : "v"(lo), "v"(hi)); return r; }
__device__ __forceinline__ float bf_lo(unsigned w) { return __uint_as_float(w << 16); }
__device__ __forceinline__ float bf_hi(unsigned w) { return __uint_as_float(w & 0xffff0000u); }
__device__ __forceinline__ float fast_sigmoid(float v) { return __builtin_amdgcn_rcpf(1.0f + __builtin_amdgcn_exp2f(-1.4426950408889634f * v)); }
__device__ __forceinline__ void unpack8(float (&o)[8], const u32x4 w) { o[0] = bf_lo(w.x); o[1] = bf_hi(w.x); o[2] = bf_lo(w.y); o[3] = bf_hi(w.y); o[4] = bf_lo(w.z); o[5] = bf_hi(w.z); o[6] = bf_lo(w.w); o[7] = bf_hi(w.w); }
__device__ __forceinline__ u32x4 pack8(const float (&o)[8]) { u32x4 w; w.x = cvt_pk_bf16(o[0], o[1]); w.y = cvt_pk_bf16(o[2], o[3]); w.z = cvt_pk_bf16(o[4], o[5]); w.w = cvt_pk_bf16(o[6], o[7]); return w; }
__device__ __forceinline__ float ssq8(const u32x4 w) { float q[8]; unpack8(q, w); float s = 0.f;
#pragma unroll
    for (int e = 0; e < 8; ++e) s += q[e] * q[e];
    return s; }

__device__ __forceinline__ unsigned q8_pack4(float a, float b, float c, float d) {
    const float M_ = 12582912.0f;
    const unsigned b0 = __float_as_uint(__builtin_amdgcn_fmed3f(a, -127.f, 127.f) + M_), b1 = __float_as_uint(__builtin_amdgcn_fmed3f(b, -127.f, 127.f) + M_);
    const unsigned b2 = __float_as_uint(__builtin_amdgcn_fmed3f(c, -127.f, 127.f) + M_), b3 = __float_as_uint(__builtin_amdgcn_fmed3f(d, -127.f, 127.f) + M_);
    return __builtin_amdgcn_perm(b1, b0, 0x0c0c0400u) | __builtin_amdgcn_perm(b3, b2, 0x04000c0cu);
}
template <int NP>
__device__ __forceinline__ float row_rstd1(const float* ssq, int row, int fq, float inv_w, int lane) {
    const float* p = ssq + (size_t)row * NP + (NP / 4) * fq; float s;
    if (NP == 32) { const f32x4 a = *(const f32x4*)p, b = *(const f32x4*)(p + 4); s = ((a[0] + a[1]) + (a[2] + a[3])) + ((b[0] + b[1]) + (b[2] + b[3])); }
    else { const f32x4 a = *(const f32x4*)p; s = (a[0] + a[1]) + (a[2] + a[3]); }
    s += shfl_xor_l(s, 16, lane); s += shfl_xor_l(s, 32, lane);
    return __builtin_amdgcn_rsqf(s * inv_w + EPS);
}
template <int NP>
__device__ __forceinline__ void row_rstd(float (&rs)[2][4], const float* ssq, int row0, int fq, float inv_w, int lane) {
    float part[2][4];
#pragma unroll
    for (int ai = 0; ai < 2; ++ai)
#pragma unroll
        for (int m = 0; m < 4; ++m) { const float* p = ssq + (size_t)(row0 + ai * HALF + m * 16) * NP + (NP / 4) * fq;
            if (NP == 32) { const f32x4 a = *(const f32x4*)p, b = *(const f32x4*)(p + 4); part[ai][m] = ((a[0] + a[1]) + (a[2] + a[3])) + ((b[0] + b[1]) + (b[2] + b[3])); }
            else { const f32x4 a = *(const f32x4*)p; part[ai][m] = (a[0] + a[1]) + (a[2] + a[3]); } }
#pragma unroll
    for (int ai = 0; ai < 2; ++ai)
#pragma unroll
        for (int m = 0; m < 4; ++m) { float s = part[ai][m]; s += shfl_xor_l(s, 16, lane); s += shfl_xor_l(s, 32, lane); rs[ai][m] = __builtin_amdgcn_rsqf(s * inv_w + EPS); }
}
template <int NP, int QIN, int QOUT>
__device__ __forceinline__ void rs_table_q(PG8_LAS float* rt, int row0, int xrow0, int tid, bool qout_on) {
    unsigned char* ws = kargs().ws; const float* ssq = (const float*)(ws + WS_SSQ); const int lane = tid & 63, r = tid >> 1, hf = tid & 1;
    const float* qin = (const float*)(ws + (QIN == 1 ? WS_QSA : WS_QSB)); float* qout = (float*)(ws + (QOUT == 1 ? WS_QSA : WS_QSB));
#pragma unroll
    for (int part = 0; part < 2; ++part) {
        if (part == 1 && !(xrow0 >= 0 && tid < 32)) break;
        const int row = (part == 0 ? row0 : xrow0) + r;
        const f32x4* p = (const f32x4*)(ssq + (size_t)row * NP + hf * (NP / 2)); float s = 0.f;
#pragma unroll
        for (int j = 0; j < NP / 8; ++j) { const f32x4 a = p[j]; s += (a[0] + a[1]) + (a[2] + a[3]); }
        s += shfl_xor_l(s, 1, lane);
        if (hf == 0) { const float rv = __builtin_amdgcn_rsqf(s * (1.0f / D) + EPS); float v = rv;
            if (QIN) v = rv * qin[row] * (1.0f / 127.0f);
            if (QOUT != 0 && qout_on) qout[row] = (QCLIP / 127.0f) * __builtin_amdgcn_rcpf(rv);
            rt[(part == 0 ? 0 : BM) + r] = v; }
    }
}
template <int NP> __device__ __forceinline__ void rs_table(PG8_LAS float* rt, int row0, int xrow0, int tid) { rs_table_q<NP, 0, 0>(rt, row0, xrow0, tid, false); }
template <int QX>
__device__ __forceinline__ void qi_table(PG8_LAS float* rt, int row0, int xrow0, int tid) {
    const float* qs = (const float*)(kargs().ws + (QX == 1 ? WS_QSA : WS_QSB));
    if (tid < BM) rt[tid] = __builtin_amdgcn_rcpf(qs[row0 + tid]);
    else if (xrow0 >= 0 && tid < BM + 16) rt[tid] = __builtin_amdgcn_rcpf(qs[xrow0 + tid - BM]);
}
template <int NP>
__device__ __forceinline__ void put_ssq(float* ssq, int row, int pn, int wc, int h, bool rider, float s, int fq, int lane) {
    s += shfl_xor_l(s, 16, lane); s += shfl_xor_l(s, 32, lane);
    if (fq == 0) { float* p = ssq + (size_t)row * NP + pn * 8 + wc; if (rider) p[h * 4] = s; else { p[0] = s; p[4] = 0.f; } }
}

template <int F>
struct EpiUp {
    int l;
    static constexpr bool PERM = true, I8 = I8U_ON; static constexpr int MID = 0, A_AUX = 0, RS_NP = 32;
    __device__ __forceinline__ void table(PG8_LAS float* rt, int row0, int xrow0, int tid, int pn) const {
        if constexpr (I8) { rs_table_q<32, (F == 0 ? 2 : 1), (F == 1 ? 2 : 0)>(rt, row0, xrow0, tid, l + 1 < DEPTH);
            if (tid < 256) rt[RS_ROWS + tid] = __uint_as_float(((const unsigned*)(kargs().ws + WS_CMAX))[(l * 2 + F) * 2 * FF + (tid >> 7) * FF + pn * HALF + (tid & 127)]); }
        else rs_table<32>(rt, row0, xrow0, tid); }
    static __device__ __forceinline__ float af(float v) { if constexpr (I8) return (float)__builtin_bit_cast(int, v); else return v; }
    __device__ __forceinline__ void operator()(const f32x4 (&acc)[2][2][4][2], const f32x4 (&accx)[2], const Unit& u, int wr, int wc, int fr, int fq, int lane, const PG8_LAS float* rt) const {
        unsigned char* ws = kargs().ws; bf16_t* Hout = (bf16_t*)(ws + WS_H);
        const int row0 = u.pm * BM + wr * 64 + fr, col0 = u.pn * HALF + wc * 32 + 8 * fq;
        float rs[2][4];
#pragma unroll
        for (int ai = 0; ai < 2; ++ai)
#pragma unroll
            for (int m = 0; m < 4; ++m) rs[ai][m] = rt[ai * HALF + wr * 64 + m * 16 + fr];
        typedef float f32x2 __attribute__((ext_vector_type(2)));
        f32x2 cg[4], cu[4];
        if constexpr (I8) { const PG8_LAS f32x4* cp = (const PG8_LAS f32x4*)(rt + RS_ROWS + wc * 32 + 8 * fq); const f32x4 a0 = cp[0], a1 = cp[1], b0 = cp[32], b1 = cp[33];
            cg[0] = (f32x2){a0[0], a0[1]}; cg[1] = (f32x2){a0[2], a0[3]}; cg[2] = (f32x2){a1[0], a1[1]}; cg[3] = (f32x2){a1[2], a1[3]};
            cu[0] = (f32x2){b0[0], b0[1]}; cu[1] = (f32x2){b0[2], b0[3]}; cu[2] = (f32x2){b1[0], b1[1]}; cu[3] = (f32x2){b1[2], b1[3]}; }
#pragma unroll
        for (int ai = 0; ai < 2; ++ai)
#pragma unroll
            for (int m = 0; m < 4; ++m) { const float r = rs[ai][m], rn = -1.4426950408889634f * r, r2 = r * r; u32x4 w;
#pragma unroll
                for (int n = 0; n < 2; ++n)
#pragma unroll
                    for (int hh = 0; hh < 2; ++hh) { f32x2 gg = {af(acc[ai][0][m][n][2 * hh]), af(acc[ai][0][m][n][2 * hh + 1])}, uu = {af(acc[ai][1][m][n][2 * hh]), af(acc[ai][1][m][n][2 * hh + 1])};
                        if constexpr (I8) { gg = gg * cg[n * 2 + hh]; uu = uu * cu[n * 2 + hh]; }
                        const f32x2 t = gg * rn; f32x2 ex; ex.x = __builtin_amdgcn_exp2f(t.x); ex.y = __builtin_amdgcn_exp2f(t.y);
                        const f32x2 dn = ex + 1.0f; f32x2 rc; rc.x = __builtin_amdgcn_rcpf(dn.x); rc.y = __builtin_amdgcn_rcpf(dn.y);
                        const f32x2 hv = ((gg * uu) * r2) * rc; const unsigned pk = cvt_pk_bf16(hv.x, hv.y);
                        if (n == 0 && hh == 0) w.x = pk; else if (n == 0) w.y = pk; else if (hh == 0) w.z = pk; else w.w = pk; }
                *(u32x4*)(Hout + (size_t)(row0 + ai * HALF + m * 16) * FF + col0) = w; }
    }
};

template <bool ROWALPHA, int MIDK, int QX>
struct EpiRes {
    static constexpr bool PERM = true, I8 = false; static constexpr int MID = MIDK, A_AUX = A_AUX_RES, RS_NP = QX ? 32 : 0;
    __device__ __forceinline__ void table(PG8_LAS float* rt, int row0, int xrow0, int tid, int) const { if constexpr (QX != 0) qi_table<QX>(rt, row0, xrow0, tid); }
    float alpha;
    __device__ __forceinline__ void mid(f32x4 (&acc)[2][2][4][2], f32x4 (&accx)[2], const Unit& u, int wr, int fr, int fq, int lane) const {
        unsigned char* ws = kargs().ws; const float* ssqA = (const float*)(ws + WS_SSQS); const float* ssqB = (const float*)(ws + WS_SSQP);
        const int row0 = u.pm * BM + wr * 64 + fr;
        float ra[2][4], rb[2][4]; row_rstd<16>(ra, ssqA, row0, fq, 1.0f / SW, lane); row_rstd<16>(rb, ssqB, row0, fq, 1.0f / PW, lane);
#pragma unroll
        for (int ai = 0; ai < 2; ++ai)
#pragma unroll
            for (int m = 0; m < 4; ++m) { const float q = ra[ai][m] / rb[ai][m];
#pragma unroll
                for (int bj = 0; bj < 2; ++bj)
#pragma unroll
                    for (int n = 0; n < 2; ++n) acc[ai][bj][m][n] = acc[ai][bj][m][n] * q; }
        const int xrow = MP + 16 * u.pm + fr; const float qx = row_rstd1<16>(ssqA, xrow, fq, 1.0f / SW, lane) / row_rstd1<16>(ssqB, xrow, fq, 1.0f / PW, lane);
        accx[0] = accx[0] * qx; accx[1] = accx[1] * qx;
    }
    __device__ __forceinline__ void operator()(const f32x4 (&acc)[2][2][4][2], const f32x4 (&accx)[2], const Unit& u, int wr, int wc, int fr, int fq, int lane, const PG8_LAS float* rt) const {
        unsigned char* ws = kargs().ws; bf16_t* XB = (bf16_t*)(ws + WS_XB); float* ssq_out = (float*)(ws + WS_SSQ); const float* ssqB = (const float*)(ws + WS_SSQP);
        const int row0 = u.pm * BM + wr * 64 + fr, col0 = u.pn * BM + wc * 32 + 8 * fq;
        float al[2][4];
        if (ROWALPHA) row_rstd<16>(al, ssqB, row0, fq, 1.0f / PW, lane);
#pragma unroll
        for (int ai = 0; ai < 2; ++ai)
#pragma unroll
            for (int m = 0; m < 4; ++m) { const int row = row0 + ai * HALF + m * 16; const float a = ROWALPHA ? al[ai][m] * alpha : alpha; float s = 0.f;
                bf16_t* br = XB + (size_t)row * D + col0;
#pragma unroll
                for (int bj = 0; bj < 2; ++bj) { float xv[8], o[8]; unpack8(xv, *(const u32x4*)(br + bj * HALF));
#pragma unroll
                    for (int n = 0; n < 2; ++n)
#pragma unroll
                        for (int e = 0; e < 4; ++e) o[n * 4 + e] = xv[n * 4 + e] + acc[ai][bj][m][n][e] * a;
                    *(u32x4*)(br + bj * HALF) = pack8(o);
                    if constexpr (QX != 0) { const float qi = rt[ai * HALF + wr * 64 + m * 16 + fr];
                        *(u32x2*)(ws + WS_XQ + (size_t)row * D + col0 + bj * HALF) = (u32x2){q8_pack4(o[0] * qi, o[1] * qi, o[2] * qi, o[3] * qi), q8_pack4(o[4] * qi, o[5] * qi, o[6] * qi, o[7] * qi)}; }
#pragma unroll
                    for (int e = 0; e < 8; ++e) s += o[e] * o[e]; }
                put_ssq<32>(ssq_out, row, u.pn, wc, 0, false, s, fq, lane);
                }
        {
            const int row = MP + 16 * u.pm + fr; const float a = ROWALPHA ? row_rstd1<16>(ssqB, row, fq, 1.0f / PW, lane) * alpha : alpha;
            bf16_t* br = XB + (size_t)row * D + col0 + wr * HALF; float xv[8], o[8]; unpack8(xv, *(const u32x4*)br);
#pragma unroll
            for (int n = 0; n < 2; ++n)
#pragma unroll
                for (int e = 0; e < 4; ++e) o[n * 4 + e] = xv[n * 4 + e] + accx[n][e] * a;
            *(u32x4*)br = pack8(o); float s = 0.f;
            if constexpr (QX != 0) { const float qi = rt[BM + fr];
                *(u32x2*)(ws + WS_XQ + (size_t)row * D + col0 + wr * HALF) = (u32x2){q8_pack4(o[0] * qi, o[1] * qi, o[2] * qi, o[3] * qi), q8_pack4(o[4] * qi, o[5] * qi, o[6] * qi, o[7] * qi)}; }
#pragma unroll
            for (int e = 0; e < 8; ++e) s += o[e] * o[e];
            put_ssq<32>(ssq_out, row, u.pn, wc, wr, true, s, fq, lane);
        }
    }
};

struct EpiIn {
    static constexpr bool PERM = true, I8 = false; static constexpr int MID = 0, A_AUX = 0, RS_NP = 32;
    __device__ __forceinline__ void table(PG8_LAS float* rt, int row0, int xrow0, int tid, int) const { rs_table_q<32, 0, (I8U_ON ? 1 : 0)>(rt, row0, xrow0, tid, true); }
    __device__ __forceinline__ void operator()(const f32x4 (&acc)[2][2][4][2], const f32x4 (&accx)[2], const Unit& u, int wr, int wc, int fr, int fq, int lane, const PG8_LAS float* rt) const {
        unsigned char* ws = kargs().ws; bf16_t* U = (bf16_t*)(ws + WS_U);
        const int row0 = u.pm * BM + wr * 64 + fr, col0 = u.pn * BM + wc * 32 + 8 * fq;
        float rs[2][4];
#pragma unroll
        for (int ai = 0; ai < 2; ++ai)
#pragma unroll
            for (int m = 0; m < 4; ++m) rs[ai][m] = rt[ai * HALF + wr * 64 + m * 16 + fr];
#pragma unroll
        for (int ai = 0; ai < 2; ++ai)
#pragma unroll
            for (int m = 0; m < 4; ++m) { bf16_t* ur = U + (size_t)(row0 + ai * HALF + m * 16) * D + col0; const float r = rs[ai][m];
#pragma unroll
                for (int bj = 0; bj < 2; ++bj) { float o[8];
#pragma unroll
                    for (int n = 0; n < 2; ++n)
#pragma unroll
                        for (int e = 0; e < 4; ++e) o[n * 4 + e] = acc[ai][bj][m][n][e] * r;
                    *(u32x4*)(ur + bj * HALF) = pack8(o); } }
        { const int row = MP + 16 * u.pm + fr; const float r = rt[BM + fr]; float o[8];
#pragma unroll
          for (int n = 0; n < 2; ++n)
#pragma unroll
              for (int e = 0; e < 4; ++e) o[n * 4 + e] = accx[n][e] * r;
          *(u32x4*)(U + (size_t)row * D + col0 + wr * HALF) = pack8(o); }
    }
};

template <int MODE>
struct EpiMix {
    static constexpr bool PERM = true, I8 = false; static constexpr int MID = 0, A_AUX = 0, RS_NP = 0;
    __device__ __forceinline__ void table(PG8_LAS float*, int, int, int, int) const {}
    int l;
    __device__ __forceinline__ u32x4 one(const f32x4 a0, const f32x4 a1, const f32x4 v0, const f32x4 v1, const bf16_t* gp) const {
        float o[8];
        if (MODE == 0) { float gg[8]; unpack8(gg, *(const u32x4*)gp);
#pragma unroll
            for (int e = 0; e < 4; ++e) { o[e] = gg[e] * fast_sigmoid(a0[e] + v0[e]); o[4 + e] = gg[4 + e] * fast_sigmoid(a1[e] + v1[e]); } }
        else {
#pragma unroll
            for (int e = 0; e < 4; ++e) { o[e] = a0[e] * v0[e]; o[4 + e] = a1[e] * v1[e]; } }
        return pack8(o);
    }
    __device__ __forceinline__ void operator()(const f32x4 (&acc)[2][2][4][2], const f32x4 (&accx)[2], const Unit& u, int wr, int wc, int fr, int fq, int lane, const PG8_LAS float* rt) const {
        const Args& ka = kargs(); unsigned char* ws = ka.ws; bf16_t* MC = (bf16_t*)(ws + WS_MC) + (MODE == 1 ? SW : 0); const bf16_t* Gb = (const bf16_t*)(ws + WS_GB);
        const float* vec = (MODE == 0 ? ka.in[20] : ka.in[22]) + l * 512; float* ssq_out = (float*)(ws + (MODE == 0 ? WS_SSQS : WS_SSQP));
        const int row0 = u.pm * BM + wr * 64 + fr, col0 = u.pn * BM + wc * 32 + 8 * fq;
        f32x4 vv[2][2];
#pragma unroll
        for (int bj = 0; bj < 2; ++bj)
#pragma unroll
            for (int n = 0; n < 2; ++n) vv[bj][n] = *(const f32x4*)(vec + col0 + bj * HALF + 4 * n);
#pragma unroll
        for (int ai = 0; ai < 2; ++ai)
#pragma unroll
            for (int m = 0; m < 4; ++m) { const int row = row0 + ai * HALF + m * 16; float s = 0.f;
#pragma unroll
                for (int bj = 0; bj < 2; ++bj) { const u32x4 w = one(acc[ai][bj][m][0], acc[ai][bj][m][1], vv[bj][0], vv[bj][1], Gb + (size_t)row * SW + col0 + bj * HALF);
                    *(u32x4*)(MC + (size_t)row * D + col0 + bj * HALF) = w; s += ssq8(w); }
                put_ssq<16>(ssq_out, row, u.pn, wc, 0, false, s, fq, lane);
                }
        { const int row = MP + 16 * u.pm + fr; const int c = col0 + wr * HALF;
          const u32x4 w = one(accx[0], accx[1], wr ? vv[1][0] : vv[0][0], wr ? vv[1][1] : vv[0][1], Gb + (size_t)row * SW + c);
          *(u32x4*)(MC + (size_t)row * D + c) = w; put_ssq<16>(ssq_out, row, u.pn, wc, wr, true, ssq8(w), fq, lane); }
    }
};
}
constexpr int RING_BYTES = 131072, RIDER_BYTES = 4096, LDSCTL_OFF = RING_BYTES + RIDER_BYTES, LDS_BYTES = 155648;

typedef unsigned short bf16;
#define LAS __attribute__((address_space(3)))
typedef unsigned v4u __attribute__((ext_vector_type(4)));
typedef unsigned v2u __attribute__((ext_vector_type(2)));
typedef float f32x4 __attribute__((ext_vector_type(4)));
typedef float f32x2 __attribute__((ext_vector_type(2)));
#define LDS_WAIT() asm volatile("s_waitcnt lgkmcnt(0)" ::: "memory")
__device__ __forceinline__ unsigned f2bf(float f) { unsigned u = __builtin_bit_cast(unsigned, f); return (u + 0x7fffu + ((u >> 16) & 1u)) >> 16; }
__device__ __forceinline__ unsigned pk2(float lo, float hi) { return f2bf(lo) | (f2bf(hi) << 16); }

#define XB_TMO      128
#define XB_XCNT(j)  (256  + 64 * (j))
#define XB_XSUB(j)  (1280 + 64 * (j))
#define XB_XGEN(j)  (2304 + 64 * (j))
#define XB_TOP      3328
#define XB_TOPGEN   3392
#define XCD_BAR_WORDS 3456
#define XB_SPIN_CAP (1u << 18)
__device__ __forceinline__ unsigned xb_ld(unsigned* p)              { return __hip_atomic_load(p, __ATOMIC_RELAXED, __HIP_MEMORY_SCOPE_AGENT); }
__device__ __forceinline__ unsigned xb_add(unsigned* p, unsigned v) { return __hip_atomic_fetch_add(p, v, __ATOMIC_RELAXED, __HIP_MEMORY_SCOPE_AGENT); }
__device__ __forceinline__ unsigned xb_xcc_id() { return (unsigned)__builtin_amdgcn_s_getreg((3 << 11) | 20) & 0xFu; }
#define XB_SPIN(cond, bar) do { unsigned _sp = 0; while (cond) { __builtin_amdgcn_s_sleep(1); \
    if ((++_sp & 255u) == 0u) { if (xb_ld(&(bar)[XB_TMO])) break; if (_sp > XB_SPIN_CAP) { atomicAdd(&(bar)[XB_TMO], 1u); break; } } } } while (0)
struct XcdBarrier { unsigned* bar; unsigned x; volatile LAS unsigned* st; };
__device__ __forceinline__ XcdBarrier xcd_barrier_post(unsigned* bar, volatile LAS unsigned* st) {
    XcdBarrier b; b.bar = bar; b.x = xb_xcc_id(); b.st = st;
    if (threadIdx.x == 0) (void)xb_add(&bar[XB_XCNT(b.x)], 1u);
    return b;
}
__device__ __forceinline__ void xcd_barrier_complete(unsigned* bar, unsigned x, unsigned& nloc, unsigned& nx) {
    const unsigned Gd = gridDim.x * gridDim.y * gridDim.z;
    unsigned sum, cnt, mine, sp = 0u;
    for (;;) {
        sum = 0u; cnt = 0u; mine = 0u;
#pragma unroll
        for (unsigned j = 0; j < 16; ++j) { const unsigned c = xb_ld(&bar[XB_XCNT(j)]); sum += c; cnt += (c > 0u) ? 1u : 0u; mine = (j == x) ? c : mine; }
        if (sum == Gd) break;
        __builtin_amdgcn_s_sleep(1);
        if ((++sp & 255u) == 0u) { if (xb_ld(&bar[XB_TMO])) break; if (sp > XB_SPIN_CAP) { atomicAdd(&bar[XB_TMO], 1u); break; } }
    }
    nloc = mine > 0u ? mine : 1u; nx = cnt > 0u ? cnt : 1u;
}
__device__ __attribute__((noinline)) void xcd_barrier_fn(unsigned* bar, unsigned x, volatile LAS unsigned* st) {
    asm volatile("s_waitcnt vmcnt(0)" ::: "memory");
    __syncthreads();
    if (threadIdx.x == 0) {
        __builtin_amdgcn_s_waitcnt(0);
        unsigned nloc = st[0], nx = st[1]; const unsigned ep = st[2];
        if (nloc == 0u) { xcd_barrier_complete(bar, x, nloc, nx); st[0] = nloc; st[1] = nx; }
        st[2] = ep + 1u;
        const unsigned old = xb_add(&bar[XB_XSUB(x)], 1u);
        if (old + 1u == (ep + 1u) * nloc) {
            __builtin_amdgcn_fence(__ATOMIC_RELEASE, "agent");
            asm volatile("s_waitcnt vmcnt(0)" ::: "memory");
            const unsigned og = xb_add(&bar[XB_TOP], 1u);
            if (og + 1u == (ep + 1u) * nx) xb_add(&bar[XB_TOPGEN], 1u);
        }
        XB_SPIN(xb_ld(&bar[XB_TOPGEN]) <= ep, bar);
        __builtin_amdgcn_fence(__ATOMIC_ACQUIRE, "agent");
        asm volatile("s_waitcnt vmcnt(0)" ::: "memory");
    }
    __syncthreads();
}

#define XL_TAB   7000
#define XL_CNT(x) (7424 + 64 * (x))
__device__ __attribute__((noinline)) void xl_barrier_fn(unsigned* ctl, volatile LAS unsigned* st) {
    asm volatile("s_waitcnt vmcnt(0)" ::: "memory");
    __syncthreads();
    if (threadIdx.x == 0) {
        const unsigned ep = st[5]; st[5] = ep + 1u; const unsigned nl = gridDim.x / 8u; unsigned* cnt = ctl + XL_CNT(blockIdx.x & 7u);
        xb_add(cnt, 1u);
        XB_SPIN(xb_ld(cnt) < (ep + 1u) * nl, ctl);
        __builtin_amdgcn_fence(__ATOMIC_ACQUIRE, "agent");
        asm volatile("s_waitcnt vmcnt(0)" ::: "memory");
    }
    __syncthreads();
}
__device__ __forceinline__ void xl_census(unsigned* ctl, volatile LAS unsigned* st) {
    const int t = threadIdx.x; int ok = 1;
    if (t < (int)gridDim.x) ok = xb_ld(ctl + XL_TAB + t) == xb_ld(ctl + XL_TAB + (t & 7));
    if (t < 8 && t > 0) { for (int j = 0; j < t; ++j) ok = ok && (xb_ld(ctl + XL_TAB + t) != xb_ld(ctl + XL_TAB + j)); }
    const int all = __syncthreads_and(ok && (gridDim.x % 8u == 0u));
#if defined(XL_FORCE_OFF)
    if (t == 0) st[4] = 0u; (void)all;
#else
    if (t == 0) st[4] = all ? 1u : 0u;
#endif
    __syncthreads();
}

struct Frame {
    LAS unsigned char* lds; int tid, lane, wave, gw, NGW;
    float* out; unsigned char* ws;
};
__device__ __forceinline__ float wave_sum(float v, int lane) {
#pragma unroll
    for (int o = 1; o < 64; o <<= 1) v += pg8::shfl_xor_l(v, o, lane);
    return v;
}
constexpr int P0_PITCH = 144, P0_SCR = 64 * P0_PITCH;
struct P0Item { const float* W; const float* gain; bf16* WT; int N, ldt, k0; const unsigned* cmax; };
constexpr int P0_PER_LAYER = 6 * 704 + 2 * 256 + 64 + 16, P0_ITEMS = DEPTH * P0_PER_LAYER;
__device__ __forceinline__ P0Item p0_decode(const Args& A, unsigned char* ws, int it) {
    const int l = it / P0_PER_LAYER; int r = it % P0_PER_LAYER; bf16* wl = (bf16*)(ws + WS_W + (size_t)l * W_LAYER);
    const float* W; const float* g = nullptr; const float* ghi = nullptr; bf16* WT; int K, N, ldt, mode = 0, roff = 0, dk0 = 0, wmi = -1;
    if (r < 704) { W = A.in[6] + (size_t)l * D * FF; K = D; N = FF; g = A.in[5] + l * D; WT = wl + W_UP1 / 2; ldt = D; mode = 1; wmi = l * 2; }
    else if ((r -= 704) < 704) { W = A.in[7] + (size_t)l * D * FF; K = D; N = FF; g = A.in[5] + l * D; WT = wl + W_UP1 / 2; ldt = D; mode = 2; wmi = l * 2; }
    else if ((r -= 704) < 704) { W = A.in[8] + (size_t)l * FF * D; K = FF; N = D; WT = wl + W_DN1 / 2; ldt = FF; }
    else if ((r -= 704) < 704) { W = A.in[27] + (size_t)l * D * FF; K = D; N = FF; g = A.in[26] + l * D; WT = wl + W_UP2 / 2; ldt = D; mode = 1; wmi = l * 2 + 1; }
    else if ((r -= 704) < 704) { W = A.in[28] + (size_t)l * D * FF; K = D; N = FF; g = A.in[26] + l * D; WT = wl + W_UP2 / 2; ldt = D; mode = 2; wmi = l * 2 + 1; }
    else if ((r -= 704) < 704) { W = A.in[29] + (size_t)l * FF * D; K = FF; N = D; WT = wl + W_DN2 / 2; ldt = FF; }
    else if ((r -= 704) < 256) { W = A.in[10] + (size_t)l * D * D; K = D; N = D; g = A.in[9] + l * D; WT = wl + W_IN / 2; ldt = D; }
    else if ((r -= 256) < 256) { W = A.in[25] + (size_t)l * D * D; K = D; N = D; g = A.in[23] + l * SW; ghi = A.in[24] + l * PW; WT = wl + W_OUT / 2; ldt = D; }
    else if ((r -= 256) < 64) { W = A.in[19] + (size_t)l * SW * SW; K = SW; N = SW; WT = wl + W_GLU / 2; ldt = SW; }
    else { r -= 64; const int gi = r >> 2; r &= 3; W = A.in[21] + ((size_t)l * 4 + gi) * 128 * 128; K = 128; N = 128; WT = wl + W_POOL / 2; ldt = 256; roff = gi * 128; dk0 = (gi & 1) * 128; }
    (void)K; const int nblk = N / 64, kb = r / nblk, nb = r % nblk, k0 = 64 * kb, n0 = 64 * nb;
    const int dr = mode == 0 ? n0 : ((n0 >> 7) * 256 + (n0 & 127) + (mode == 2 ? 128 : 0));
    P0Item I; I.W = W + (size_t)k0 * N + n0; I.gain = g ? ((ghi && k0 >= 512) ? ghi + (k0 - 512) : g + k0) : nullptr; I.WT = WT + (size_t)(roff + dr) * ldt + dk0 + k0; I.N = N; I.ldt = ldt; I.k0 = k0; I.cmax = nullptr;
    if (I8U_ON && wmi >= 0) { I.WT = (bf16*)((unsigned char*)WT + (size_t)dr * D + k0); I.cmax = (const unsigned*)(ws + WS_CMAX) + wmi * 2 * FF + (mode == 2 ? FF : 0) + n0; }
    return I;
}
__device__ __forceinline__ void p0_load(const P0Item& I, f32x4 (&r0)[8], f32x4 (&r1)[8], int lane) {
    const int q = lane & 15, kp = lane >> 4;
#pragma unroll
    for (int s = 0; s < 8; ++s) { const float* wp = I.W + (size_t)(8 * s + 2 * kp) * I.N + 4 * q; r0[s] = __builtin_nontemporal_load((const f32x4*)wp); r1[s] = __builtin_nontemporal_load((const f32x4*)(wp + I.N)); }
}
__device__ __forceinline__ void p0_finish(const P0Item& I, const f32x4 (&r0)[8], const f32x4 (&r1)[8], LAS unsigned char* scr, int lane) {
    const int q = lane & 15, kp = lane >> 4;
    if (I8U_ON && I.cmax != nullptr) {
        const float M_ = 12582912.0f; float qj[4];
#pragma unroll
        for (int j = 0; j < 4; ++j) qj[j] = 127.0f / fmaxf(__uint_as_float(I.cmax[4 * q + j]), 1e-30f);
#pragma unroll
        for (int s = 0; s < 8; ++s) { const float g0 = I.gain[8 * s + 2 * kp], g1 = I.gain[8 * s + 2 * kp + 1];
#pragma unroll
            for (int j = 0; j < 4; ++j) { const unsigned b0 = __float_as_uint(__builtin_amdgcn_fmed3f(r0[s][j] * g0 * qj[j], -127.f, 127.f) + M_), b1 = __float_as_uint(__builtin_amdgcn_fmed3f(r1[s][j] * g1 * qj[j], -127.f, 127.f) + M_);
                *(LAS unsigned short*)(scr + (4 * q + j) * 80 + 8 * s + 2 * kp) = (unsigned short)((b0 & 0xffu) | ((b1 & 0xffu) << 8)); } }
        LDS_WAIT(); asm volatile("" ::: "memory");
#pragma unroll
        for (int i = 0; i < 4; ++i) { const int n = i * 16 + (lane >> 2), c = lane & 3; const v4u o = *(const LAS v4u*)(scr + n * 80 + c * 16);
            *(v4u*)((unsigned char*)I.WT + (size_t)n * D + 16 * c) = o; }
        LDS_WAIT(); asm volatile("" ::: "memory");
        return;
    }
#pragma unroll
    for (int s = 0; s < 8; ++s) { float g0 = 1.f, g1 = 1.f; if (I.gain) { g0 = I.gain[8 * s + 2 * kp]; g1 = I.gain[8 * s + 2 * kp + 1]; }
#pragma unroll
        for (int j = 0; j < 4; ++j) *(LAS unsigned*)(scr + (4 * q + j) * P0_PITCH + (4 * s + kp) * 4) = pg8::cvt_pk_bf16(r0[s][j] * g0, r1[s][j] * g1); }
    LDS_WAIT(); asm volatile("" ::: "memory");
    const int c = lane & 7;
#pragma unroll
    for (int i = 0; i < 8; ++i) { const int n = i * 8 + (lane >> 3); const v4u o = *(const LAS v4u*)(scr + n * P0_PITCH + c * 16);
        *(v4u*)(I.WT + (size_t)n * I.ldt + 8 * c) = o; }
    LDS_WAIT(); asm volatile("" ::: "memory");
}
__device__ __forceinline__ void init_row(const Frame& F, const float* src, bf16* xb, float* ssq, unsigned* xq, float* qs) {
    const f32x4* xr = (const f32x4*)src + F.lane; f32x4 v[4]; float s = 0.f; v2u w[4];
#pragma unroll
    for (int j = 0; j < 4; ++j) v[j] = __builtin_nontemporal_load(xr + 64 * j);
#pragma unroll
    for (int j = 0; j < 4; ++j) { w[j].x = pg8::cvt_pk_bf16(v[j].x, v[j].y); w[j].y = pg8::cvt_pk_bf16(v[j].z, v[j].w);
        const float a = pg8::bf_lo(w[j].x), b = pg8::bf_hi(w[j].x), c = pg8::bf_lo(w[j].y), d = pg8::bf_hi(w[j].y); s += (a * a + b * b) + (c * c + d * d); }
    s = wave_sum(s, F.lane);
#pragma unroll
    for (int j = 0; j < 4; ++j) ((v2u*)xb + F.lane)[64 * j] = w[j];
    if (F.lane < 32) ssq[F.lane] = F.lane == 0 ? s : 0.f;
    if (I8U_ON) { const float rv = __builtin_amdgcn_rsqf(s * (1.0f / D) + EPS), qi = rv * (127.0f / QCLIP0);
#pragma unroll
        for (int j = 0; j < 4; ++j) xq[F.lane + 64 * j] = pg8::q8_pack4(v[j].x * qi, v[j].y * qi, v[j].z * qi, v[j].w * qi);
        if (F.lane == 0) *qs = (QCLIP0 / 127.0f) * __builtin_amdgcn_rcpf(rv); }
}
struct S5Coef { float ar, ai, kr, ki; };
__device__ __forceinline__ S5Coef s5_coef(const Args& A, int l, int g, int p) {
    const float dt = expf(A.in[13][l * G + g]), lr = A.in[11][(l * G + g) * P + p], li = A.in[12][(l * G + g) * P + p];
    const float mag = expf(lr * dt); S5Coef c; c.ar = mag * cosf(li * dt); c.ai = mag * sinf(li * dt);
    const float den = lr * lr + li * li, nr = c.ar - 1.0f, ni = c.ai; c.kr = (nr * lr + ni * li) / den; c.ki = (ni * lr - nr * li) / den; return c;
}
typedef short bf16x8_t __attribute__((ext_vector_type(8)));
typedef float f32x16 __attribute__((ext_vector_type(16)));
constexpr int TR_PITCH = 272;
__device__ __forceinline__ float gelu_fast(float y) { const float z = 0.7978845608028654f * (y + 0.044715f * y * y * y); return y * __builtin_amdgcn_rcpf(1.0f + __builtin_amdgcn_exp2f(-2.0f * 1.4426950408889634f * z)); }

struct S5Tab { bf16x8_t tbb[4]; f32x2 a0, a1; bf16x8_t tc[4]; f32x4 dv; };
struct S5In { bf16x8_t af[2]; float hr0, hi0, hr1, hi1; v2u uw[2][2]; };
template <bool FINAL>
__device__ __forceinline__ void s5_load_tab(S5Tab& T, const Frame& F, const Args& A, const int l, const int g) {
    const unsigned char* tab = F.ws + WS_TAB; const int lane = F.lane, sg = lane & 31;
#pragma unroll
    for (int j = 0; j < 4; ++j) T.tbb[j] = ((const bf16x8_t*)(tab + TAB_BB))[((l * G + g) * 4 + j) * 64 + lane];
    T.a0 = ((const f32x2*)(tab + TAB_A))[(l * G + g) * P + sg]; T.a1 = ((const f32x2*)(tab + TAB_A))[(l * G + g) * P + sg + 32];
    if (FINAL) {
#pragma unroll
        for (int s = 0; s < 4; ++s) T.tc[s] = ((const bf16x8_t*)(tab + TAB_C))[((l * G + g) * 4 + s) * 64 + lane];
        T.dv = *(const f32x4*)(A.in[18] + (l * G + g) * H + 4 * (lane >> 4));
    }
}
template <bool FINAL>
__device__ __forceinline__ void s5_load_in(S5In& I, const Frame& F, const int row0, const int g) {
    const int lane = F.lane, sg = lane & 31, hf = lane >> 5, r = lane & 31;
    const bf16* up = (const bf16*)(F.ws + WS_U) + (size_t)(row0 + 32 * ((r >> 2) & 1) + (r & 3) + 4 * (r >> 3)) * D + g * H + 8 * hf;
    I.af[0] = *(const bf16x8_t*)up; I.af[1] = *(const bf16x8_t*)(up + (size_t)16 * D);
    I.hr0 = 0.f; I.hi0 = 0.f; I.hr1 = 0.f; I.hi1 = 0.f;
    if (FINAL) { const float* hinr = (const float*)(F.ws + WS_E + 2 * E_BYTES); const float* hini = (const float*)(F.ws + WS_E + 3 * E_BYTES);
        const size_t o = ((size_t)(row0 / 32 + hf) * G + g) * P + sg; I.hr0 = hinr[o]; I.hi0 = hini[o]; I.hr1 = hinr[o + 32]; I.hi1 = hini[o + 32];
        const int fr = lane & 15, fq = lane >> 4;
#pragma unroll
        for (int i = 0; i < 2; ++i)
#pragma unroll
            for (int rt = 0; rt < 2; ++rt) I.uw[i][rt] = *(const v2u*)((const bf16*)(F.ws + WS_U) + (size_t)(row0 + 32 * rt + 16 * i + fr) * D + g * H + 4 * fq); }
}
template <bool FINAL>
__device__ __forceinline__ void s5_unit(const Frame& F, const S5Tab& T, const S5In& I, const int row0, const int g, LAS unsigned char* tr) {
    const int lane = F.lane, sg = lane & 31, hf = lane >> 5;
    float hr0 = I.hr0, hi0 = I.hi0, hr1 = I.hr1, hi1 = I.hi1; const f32x2 a0 = T.a0, a1 = T.a1;
#pragma unroll
    for (int i = 0; i < 2; ++i) {
        const f32x16 z = {0.f, 0.f, 0.f, 0.f, 0.f, 0.f, 0.f, 0.f, 0.f, 0.f, 0.f, 0.f, 0.f, 0.f, 0.f, 0.f};
        const f32x16 x0 = __builtin_amdgcn_mfma_f32_32x32x16_bf16(I.af[i], T.tbb[0], z, 0, 0, 0);
        const f32x16 x1 = __builtin_amdgcn_mfma_f32_32x32x16_bf16(I.af[i], T.tbb[1], z, 0, 0, 0);
        const f32x16 x2 = __builtin_amdgcn_mfma_f32_32x32x16_bf16(I.af[i], T.tbb[2], z, 0, 0, 0);
        const f32x16 x3 = __builtin_amdgcn_mfma_f32_32x32x16_bf16(I.af[i], T.tbb[3], z, 0, 0, 0);
#pragma unroll
        for (int t = 0; t < 16; ++t) {
            const float n0r = __builtin_fmaf(-a0.y, hi0, __builtin_fmaf(a0.x, hr0, x0[t])), n0i = __builtin_fmaf(a0.y, hr0, __builtin_fmaf(a0.x, hi0, x2[t]));
            const float n1r = __builtin_fmaf(-a1.y, hi1, __builtin_fmaf(a1.x, hr1, x1[t])), n1i = __builtin_fmaf(a1.y, hr1, __builtin_fmaf(a1.x, hi1, x3[t]));
            hr0 = n0r; hi0 = n0i; hr1 = n1r; hi1 = n1i;
            if (FINAL) { v2u w; w.x = pg8::cvt_pk_bf16(hr0, hi0); w.y = pg8::cvt_pk_bf16(hr1, hi1); *(LAS v2u*)(tr + (hf * 16 + t) * TR_PITCH + 8 * sg) = w; }
        }
        if (FINAL) {
            const int fr = lane & 15, fq = lane >> 4;
#pragma unroll
            for (int rt = 0; rt < 2; ++rt) {
                f32x4 acc = {0.f, 0.f, 0.f, 0.f};
#pragma unroll
                for (int s = 0; s < 4; ++s) { const bf16x8_t hb = *(const LAS bf16x8_t*)(tr + (rt * 16 + fr) * TR_PITCH + s * 64 + fq * 16);
                    acc = __builtin_amdgcn_mfma_f32_16x16x32_bf16(T.tc[s], hb, acc, 0, 0, 0); }
                const int trow = row0 + 32 * rt + 16 * i + fr;
                const v2u uw = I.uw[i][rt];
                const float uv[4] = {pg8::bf_lo(uw.x), pg8::bf_hi(uw.x), pg8::bf_lo(uw.y), pg8::bf_hi(uw.y)};
                float y[4];
#pragma unroll
                for (int e = 0; e < 4; ++e) y[e] = gelu_fast(acc[e] + T.dv[e] * uv[e]);
                v2u w; w.x = pg8::cvt_pk_bf16(y[0], y[1]); w.y = pg8::cvt_pk_bf16(y[2], y[3]);
                *(v2u*)((bf16*)(F.ws + WS_GB) + (size_t)trow * SW + g * H + 4 * fq) = w;
            }
            asm volatile("s_waitcnt lgkmcnt(0)" ::: "memory");
        }
    }
    if (!FINAL) {
        float* er = (float*)(F.ws + WS_E); float* ei = (float*)(F.ws + WS_E + E_BYTES);
        const size_t o = ((size_t)(row0 / 32 + hf) * G + g) * P + sg; er[o] = hr0; ei[o] = hi0; er[o + 32] = hr1; ei[o + 32] = hi1;
    }
}
__device__ __forceinline__ int s5_chunk_of(int lu, int x) { const int cl = lu / G; return cl < 32 ? 32 * x + cl : MP / 64 + 2 * x + (cl - 32); }
template <bool FINAL>
__device__ __forceinline__ void s5_units(const Frame& F, const Args& A, const int l, LAS unsigned char* tr) {
    constexpr int NUL = 34 * G;
    const int x = blockIdx.x & 7, lw = (blockIdx.x >> 3) * 8 + F.wave, nlw = (gridDim.x >> 3) * 8;
    int it = lw; if (it >= NUL) return;
    S5Tab T; int gl = it % G; s5_load_tab<FINAL>(T, F, A, l, gl);
    S5In cur; s5_load_in<FINAL>(cur, F, s5_chunk_of(it, x) * 64, gl);
    for (;;) {
        const int nx = it + nlw; S5In nxt = cur; const int gn = nx % G;
        if (nx < NUL) s5_load_in<FINAL>(nxt, F, s5_chunk_of(nx, x) * 64, gn);
        s5_unit<FINAL>(F, T, cur, s5_chunk_of(it, x) * 64, gl, tr);
        if (nx >= NUL) break;
        if (gn != gl) { s5_load_tab<FINAL>(T, F, A, l, gn); gl = gn; }
        cur = nxt; it = nx;
    }
}

template <int W>
__device__ __forceinline__ void pool_unit(const Frame& F, const float* hist, const int sc, const int grp) {
    const int rowb = sc * 32, c = grp * 128 + 2 * F.lane; const bool prompt = rowb < MP;
    const int t0 = prompt ? (rowb & (PL - 1)) : ((rowb - MP) & (SL - 1)), strm = prompt ? 0 : (rowb - MP) / SL;
    const bf16* ucol = (const bf16*)(F.ws + WS_U) + (size_t)rowb * D + SW + c; bf16* pcol = (bf16*)(F.ws + WS_PRE) + (size_t)rowb * PW + c;
    f32x2 v[31 + W];
    if (t0 == 0) {
#pragma unroll
        for (int dt = -(W - 1); dt < 0; ++dt) v[dt + W - 1] = prompt ? (f32x2){0.f, 0.f} : *(const f32x2*)(hist + ((size_t)strm * HIST + (HIST + dt)) * PW + c);
    } else {
#pragma unroll
        for (int dt = -(W - 1); dt < 0; ++dt) { const unsigned w = *(const unsigned*)(ucol + (ptrdiff_t)dt * D); v[dt + W - 1] = (f32x2){pg8::bf_lo(w), pg8::bf_hi(w)}; }
    }
#pragma unroll
    for (int dt = 0; dt < 32; ++dt) { const unsigned w = *(const unsigned*)(ucol + (size_t)dt * D); v[dt + W - 1] = (f32x2){pg8::bf_lo(w), pg8::bf_hi(w)}; }
    f32x2 s = {0.f, 0.f};
#pragma unroll
    for (int j = 0; j < W - 1; ++j) s += v[j];
    const bool head = prompt && t0 == 0;
#pragma unroll
    for (int dt = 0; dt < 32; ++dt) {
        s += v[dt + W - 1];
        const float inv = head ? 1.0f / (float)(dt + 1 < W ? dt + 1 : W) : 1.0f / (float)W;
        const f32x2 pre = s * inv - v[dt + W - 1];
        *(unsigned*)(pcol + (size_t)dt * PW) = pg8::cvt_pk_bf16(pre.x, pre.y);
        s -= v[dt];
    }
}

template <int PART>
__device__ __forceinline__ void phase_m1(const Frame& F, const Args& A, const int l) {
    if (PART & 1) s5_units<false>(F, A, l, nullptr);
    if (!(PART & 2)) return;
    const float* hist = A.in[4] + (size_t)l * SB * HIST * PW;
    for (int it = F.gw; it < NSC * 4; it += F.NGW) {
        const int sc = it >> 2, grp = it & 3;
        if (grp == 0) pool_unit<2>(F, hist, sc, 0); else if (grp == 1) pool_unit<4>(F, hist, sc, 1); else if (grp == 2) pool_unit<8>(F, hist, sc, 2); else pool_unit<16>(F, hist, sc, 3);
    }
    float* tail_p = F.out + (size_t)M * D + 2 * DEPTH * PB * G * P + (size_t)l * PB * HIST * PW;
    float* tail_s = F.out + (size_t)M * D + 2 * DEPTH * PB * G * P + DEPTH * PB * HIST * PW + 2 * DEPTH * SB * G * P + (size_t)l * SB * HIST * PW;
    for (int it = F.gw; it < (PB + SB) * HIST; it += F.NGW) {
        const int strm = it / HIST, k = it % HIST; const bool prompt = strm < PB;
        const int row = prompt ? strm * PL + PL - HIST + k : MP + (strm - PB) * SL + SL - HIST + k;
        const v4u w = *((const v4u*)((const bf16*)(F.ws + WS_U) + (size_t)row * D + SW) + F.lane);
        f32x4* dst = (f32x4*)((prompt ? tail_p + (size_t)strm * HIST * PW : tail_s + (size_t)(strm - PB) * HIST * PW) + (size_t)k * PW) + 2 * F.lane;
        dst[0] = (f32x4){pg8::bf_lo(w.x), pg8::bf_hi(w.x), pg8::bf_lo(w.y), pg8::bf_hi(w.y)}; dst[1] = (f32x4){pg8::bf_lo(w.z), pg8::bf_hi(w.z), pg8::bf_lo(w.w), pg8::bf_hi(w.w)};
    }
}

__device__ __forceinline__ void phase_m2(const Frame& F, const Args& A, const int l, const int bid) {
    phase_m1<2>(F, A, l);
    const float* er = (const float*)(F.ws + WS_E); const float* ei = (const float*)(F.ws + WS_E + E_BYTES);
    float* hinr = (float*)(F.ws + WS_E + 2 * E_BYTES); float* hini = (float*)(F.ws + WS_E + 3 * E_BYTES);
    const unsigned char* tab = F.ws + WS_TAB;
    float* o_re_p = F.out + (size_t)M * D, *o_im_p = o_re_p + DEPTH * PB * G * P;
    float* o_re_s = o_im_p + DEPTH * PB * G * P + DEPTH * PB * HIST * PW, *o_im_s = o_re_s + DEPTH * SB * G * P;
    if (bid < 128) {
        const int b = bid >> 6, gp = (bid & 63) * 32 + (F.tid & 31), seg = F.tid >> 5;
        const f32x2 a32 = ((const f32x2*)(tab + TAB_A32))[l * G * P + gp];
        const size_t base = ((size_t)b * 256 + seg * 16) * (G * P) + gp;
        float e_r[16], e_i[16];
#pragma unroll
        for (int c = 0; c < 16; ++c) { e_r[c] = er[base + (size_t)c * (G * P)]; e_i[c] = ei[base + (size_t)c * (G * P)]; }
        float hr = 0.f, hi = 0.f;
#pragma unroll
        for (int c = 0; c < 16; ++c) { const float nr = a32.x * hr - a32.y * hi + e_r[c], ni = a32.x * hi + a32.y * hr + e_i[c]; hr = nr; hi = ni; }
        LAS f32x2* sf = (LAS f32x2*)F.lds;
        sf[seg * 32 + (F.tid & 31)] = (f32x2){hr, hi};
        float pr = a32.x, pi = a32.y;
#pragma unroll
        for (int s = 0; s < 4; ++s) { const float nr = pr * pr - pi * pi, ni = 2.0f * pr * pi; pr = nr; pi = ni; }
        __syncthreads();
        hr = 0.f; hi = 0.f;
        for (int s = 0; s < seg; ++s) { const f32x2 f = sf[s * 32 + (F.tid & 31)]; const float nr = pr * hr - pi * hi + f.x, ni = pr * hi + pi * hr + f.y; hr = nr; hi = ni; }
#pragma unroll
        for (int c = 0; c < 16; ++c) { hinr[base + (size_t)c * (G * P)] = hr; hini[base + (size_t)c * (G * P)] = hi;
            const float nr = a32.x * hr - a32.y * hi + e_r[c], ni = a32.x * hi + a32.y * hr + e_i[c]; hr = nr; hi = ni; }
        if (seg == 15) { o_re_p[((size_t)l * PB + b) * (G * P) + gp] = hr; o_im_p[((size_t)l * PB + b) * (G * P) + gp] = hi; }
        __syncthreads();
    } else {
        for (int i = (bid - 128) * 512 + F.tid; i < SB * G * P; i += 128 * 512) {
            const int s = i / (G * P), gp = i % (G * P);
            const f32x2 a32 = ((const f32x2*)(tab + TAB_A32))[l * G * P + gp];
            float hr = A.in[2][((size_t)l * SB + s) * (G * P) + gp], hi = A.in[3][((size_t)l * SB + s) * (G * P) + gp];
            const size_t base = ((size_t)(MP / 32) + 2 * s) * (G * P) + gp;
#pragma unroll
            for (int c = 0; c < 2; ++c) { hinr[base + (size_t)c * (G * P)] = hr; hini[base + (size_t)c * (G * P)] = hi;
                const float e0 = er[base + (size_t)c * (G * P)], e1 = ei[base + (size_t)c * (G * P)];
                const float nr = a32.x * hr - a32.y * hi + e0, ni = a32.x * hi + a32.y * hr + e1; hr = nr; hi = ni; }
            o_re_s[((size_t)l * SB + s) * (G * P) + gp] = hr; o_im_s[((size_t)l * SB + s) * (G * P) + gp] = hi;
        }
    }
}

__device__ __forceinline__ void phase_m3(const Frame& F, const Args& A, const int l) {
    s5_units<true>(F, A, l, F.lds + F.wave * (32 * TR_PITCH));
}

#define MIXER_M1(L) phase_m1<1>(F, a, L);
#define MIXER_M2(L) phase_m2(F, a, L, bid);
#define MIXER_M3(L) phase_m3(F, a, L);
#if defined(DEFER_L1)
constexpr int P0_DEFER = DEFER_L1;
constexpr int P0_EARLY_ITEMS = P0_ITEMS - 2 * P0_DEFER;
#else
constexpr int P0_EARLY_ITEMS = P0_ITEMS;
#endif
__device__ __forceinline__ void p0_convert(const Frame& F, const Args& A, LAS unsigned char* scr, const int lo, const int hi, const int w, const int nw) {
    int it = lo + w;
    if (it < hi) {
        P0Item cur = p0_decode(A, F.ws, it); f32x4 r0[8], r1[8]; p0_load(cur, r0, r1, F.lane);
        for (;;) {
            const int nx = it + nw; const bool more = nx < hi; P0Item nxt = cur; f32x4 n0[8], n1[8];
            if (more) { nxt = p0_decode(A, F.ws, nx); p0_load(nxt, n0, n1, F.lane); }
            p0_finish(cur, r0, r1, scr, F.lane);
            if (!more) break;
#pragma unroll
            for (int s = 0; s < 8; ++s) { r0[s] = n0[s]; r1[s] = n1[s]; }
            cur = nxt; it = nx;
        }
    }
}
__device__ __forceinline__ void phase_wmax(const Frame& F, const Args& A) {
    LAS float* red = (LAS float*)F.lds; const int nblk = F.NGW / 8, blk = F.gw / 8;
    constexpr int NCB = FF / 256, NT = 2 * DEPTH * 2 * NCB * 8;
    for (int t = blk; t < NT; t += nblk) {
        const int kc = t & 7, cb = (t >> 3) % NCB, mi = (t >> 3) / NCB, gu = mi & 1, f = (mi >> 1) & 1, l = mi >> 2;
        const float* W = A.in[f == 0 ? (gu == 0 ? 6 : 7) : (gu == 0 ? 27 : 28)] + ((size_t)l * D + kc * 128 + F.wave * 16) * FF + cb * 256 + 4 * F.lane;
        const float* gp = A.in[f == 0 ? 5 : 26] + l * D + kc * 128 + F.wave * 16;
        f32x4 v[16];
#pragma unroll
        for (int i = 0; i < 16; ++i) v[i] = *(const f32x4*)(W + (size_t)i * FF);
        f32x4 m = {0.f, 0.f, 0.f, 0.f};
#pragma unroll
        for (int i = 0; i < 16; ++i) { const float g = fabsf(gp[i]); m.x = fmaxf(m.x, fabsf(v[i].x) * g); m.y = fmaxf(m.y, fabsf(v[i].y) * g); m.z = fmaxf(m.z, fabsf(v[i].z) * g); m.w = fmaxf(m.w, fabsf(v[i].w) * g); }
        *(LAS f32x4*)(red + F.wave * 256 + 4 * F.lane) = m;
        __syncthreads();
        if (F.tid < 256) { float mx = 0.f;
#pragma unroll
            for (int w = 0; w < 8; ++w) mx = fmaxf(mx, red[w * 256 + F.tid]);
            __hip_atomic_fetch_max((unsigned*)(F.ws + WS_CMAX) + (l * 2 + f) * 2 * FF + gu * FF + cb * 256 + F.tid, __float_as_uint(mx), __ATOMIC_RELAXED, __HIP_MEMORY_SCOPE_AGENT); }
        __syncthreads();
    }
}
__device__ __forceinline__ void phase_p0(const Frame& F, const Args& A) {
    LAS unsigned char* scr = F.lds + F.wave * P0_SCR;
#define in A.in
    p0_convert(F, A, scr, 0, P0_EARLY_ITEMS, F.gw, F.NGW);
    for (int l = 0; l < DEPTH; ++l) {
        bf16* wl = (bf16*)(F.ws + WS_W + (size_t)l * W_LAYER);
        for (int i = F.gw * 64 + F.lane; i < 512 * 16; i += F.NGW * 64) { const int n = i >> 4, c = i & 15, gi = n >> 7;
            *(v4u*)(wl + W_POOL / 2 + (size_t)n * 256 + ((gi & 1) ^ 1) * 128 + c * 8) = (v4u){0u, 0u, 0u, 0u}; }
    }
    for (int m = F.gw; m < M; m += F.NGW) {
        const float* src = m < MP ? in[0] + (size_t)m * D : in[1] + (size_t)(m - MP) * D;
        init_row(F, src, (bf16*)(F.ws + WS_XB) + (size_t)m * D, (float*)(F.ws + WS_SSQ) + (size_t)m * 32, (unsigned*)(F.ws + WS_XQ + (size_t)m * D), (float*)(F.ws + WS_QSB) + m);
    }
    unsigned char* tab = F.ws + WS_TAB;
    for (int i = F.gw * 64 + F.lane; i < DEPTH * G * P; i += F.NGW * 64) {
        const int p = i % P, g = (i / P) % G, l = i / (P * G); const S5Coef c = s5_coef(A, l, g, p);
        ((f32x2*)(tab + TAB_A))[i] = (f32x2){c.ar, c.ai};
        float r = c.ar, im = c.ai;
#pragma unroll
        for (int s = 0; s < 5; ++s) { const float nr = r * r - im * im, ni = 2.0f * r * im; r = nr; im = ni; }
        ((f32x2*)(tab + TAB_A32))[i] = (f32x2){r, im};
    }
    for (int i = F.gw * 64 + F.lane; i < DEPTH * G * 4 * 64; i += F.NGW * 64) {
        const int ln = i & 63, j = (i >> 6) & 3, g = (i >> 8) % G, l = i / (256 * G);
        {
            const int c = ln & 31, hf = ln >> 5, p = 32 * (j & 1) + c; const S5Coef cf = s5_coef(A, l, g, p); float v[8];
#pragma unroll
            for (int e = 0; e < 8; ++e) { const int ch = 8 * hf + e; const float br = in[14][((size_t)(l * G + g) * P + p) * H + ch], bi = in[15][((size_t)(l * G + g) * P + p) * H + ch];
                v[e] = j < 2 ? cf.kr * br - cf.ki * bi : cf.kr * bi + cf.ki * br; }
            ((v4u*)(tab + TAB_BB))[i] = (v4u){pk2(v[0], v[1]), pk2(v[2], v[3]), pk2(v[4], v[5]), pk2(v[6], v[7])};
        }
        {
            const int ch = ln & 15, fq = ln >> 4; float v[8];
#pragma unroll
            for (int e = 0; e < 8; ++e) { const int k = 32 * j + 8 * fq + e, sg = k >> 2, comp = k & 3, p = sg + 32 * (comp >> 1);
                v[e] = (comp & 1) ? -in[17][((size_t)(l * G + g) * H + ch) * P + p] : in[16][((size_t)(l * G + g) * H + ch) * P + p]; }
            ((v4u*)(tab + TAB_C))[i] = (v4u){pk2(v[0], v[1]), pk2(v[2], v[3]), pk2(v[4], v[5]), pk2(v[6], v[7])};
        }
    }
}
#undef in
__device__ __forceinline__ void phase_fin(const Frame& F, const Args& A) {
    const float* gn = A.in[30];
    for (int m = F.gw; m < M; m += F.NGW) {
        const float* sp = (const float*)(F.ws + WS_SSQ) + (size_t)m * 32; float s = F.lane < 32 ? sp[F.lane] : 0.f; s = wave_sum(s, F.lane);
        const float r = __builtin_amdgcn_rsqf(s * (1.0f / D) + EPS);
        const v2u* xr = (const v2u*)((const bf16*)(F.ws + WS_XB) + (size_t)m * D) + F.lane; f32x4* yr = (f32x4*)(F.out + (size_t)m * D) + F.lane; const f32x4* gr = (const f32x4*)gn + F.lane;
#pragma unroll
        for (int j = 0; j < 4; ++j) { const v2u w = xr[64 * j]; const f32x4 gg = gr[64 * j];
            __builtin_nontemporal_store((f32x4){pg8::bf_lo(w.x) * r * gg.x, pg8::bf_hi(w.x) * r * gg.y, pg8::bf_lo(w.y) * r * gg.z, pg8::bf_hi(w.y) * r * gg.w}, yr + 64 * j); }
    }
}
#define PH_SETUP \
    const int tid_ = wid0 * 64 + pg8::fresh_lane(); const Args& a = kargs(); unsigned char* ws_ = a.ws; \
    Frame F; F.lds = (LAS unsigned char*)lds_raw; F.tid = tid_; F.lane = F.tid & 63; F.wave = wid0; \
    const int Gd = gridDim.x, bid = blockIdx.x; \
    { const int vcu = (Gd % 8 == 0) ? (bid % 8) * (Gd / 8) + bid / 8 : bid; F.gw = vcu * 8 + F.wave; F.NGW = Gd * 8; } \
    F.out = a.out; F.ws = ws_; (void)Gd; (void)bid;

template <int L, int K, bool DRY>
__device__ __forceinline__ void run_phase(unsigned char* lds_raw, const int wid0) {
    PH_SETUP
    constexpr size_t WL = WS_W + (size_t)(L < 0 ? 0 : L) * W_LAYER;
    if constexpr (K == 100) phase_p0(F, a);
    else if constexpr (K == 102) phase_wmax(F, a);
    else if constexpr (K == 101) phase_fin(F, a);
    else if constexpr (K == 0 || K == 8) {
        constexpr int KE = I8U_ON ? D / 2 : D;
        pg8::Gemm g{(bf16*)(ws_ + (I8U_ON ? WS_XQ : WS_XB)), (bf16*)(ws_ + WL + (K == 0 ? W_UP1 : W_UP2)), KE, KE, KE, 0, 0}; pg8::StaticOrder S; S.init(M, 2 * FF, KE, Gd, bid);
        if constexpr (K == 0) { pg8::EpiUp<0> E{L}; pg8::gemm_phase<false>(F.lds, F.tid, F.wave, g, S, E); } else { pg8::EpiUp<1> E{L}; pg8::gemm_phase<false>(F.lds, F.tid, F.wave, g, S, E); }
#if defined(DEFER_L1)
        if constexpr (L == 0 && !DRY) {
            constexpr int NT = (M / 256) * (2 * FF / 256); const int nlast = NT - (NT / Gd) * Gd, nidle = Gd - nlast;
            if (nlast > 0 && bid >= nlast) { const int lo = P0_EARLY_ITEMS + (K == 0 ? 0 : P0_DEFER), hi = lo + P0_DEFER;
                const int lane2 = pg8::fresh_lane(); Frame F2 = F; F2.lane = lane2; F2.tid = wid0 * 64 + lane2;
                p0_convert(F2, a, F.lds + F.wave * P0_SCR, lo, hi, (bid - nlast) * 8 + F.wave, nidle * 8); }
        }
#endif
    } else if constexpr (K == 1 || K == 9) {
        pg8::Gemm g{(bf16*)(ws_ + WS_H), (bf16*)(ws_ + WL + (K == 1 ? W_DN1 : W_DN2)), FF, FF, FF, 0, MP}; pg8::StaticOrder S; S.init(MP, D, FF, Gd, bid);
        if constexpr (I8U_ON && K == 9 && L + 1 < DEPTH) { pg8::EpiRes<false, 0, 2> E{DRY ? 0.f : 0.5f}; pg8::gemm_phase<true>(F.lds, F.tid, F.wave, g, S, E); }
        else { pg8::EpiRes<false, 0, 0> E{DRY ? 0.f : 0.5f}; pg8::gemm_phase<true>(F.lds, F.tid, F.wave, g, S, E); }
    } else if constexpr (K == 2) {
        pg8::Gemm g{(bf16*)(ws_ + WS_XB), (bf16*)(ws_ + WL + W_IN), D, D, D, 0, MP}; pg8::StaticOrder S; S.init(MP, D, D, Gd, bid);
        pg8::EpiIn E{}; pg8::gemm_phase<true>(F.lds, F.tid, F.wave, g, S, E);
    } else if constexpr (K == 3) { MIXER_M1(L) }
    else if constexpr (K == 4) { MIXER_M2(L) }
    else if constexpr (K == 5) { MIXER_M3(L) }
    else if constexpr (K == 6) {
        const int hg = Gd / 2;
        { pg8::Gemm g{(bf16*)(ws_ + WS_GB), (bf16*)(ws_ + WL + W_GLU), SW, SW, SW, 0, MP}; pg8::StaticOrder S; S.init(MP, SW, SW, hg, bid < hg ? bid : -1);
          pg8::EpiMix<0> E{L}; pg8::gemm_phase<true>(F.lds, F.tid, F.wave, g, S, E); }
        { pg8::Gemm g{(bf16*)(ws_ + WS_PRE), (bf16*)(ws_ + WL + W_POOL), 256, PW, 256, 256, MP}; pg8::StaticOrder S; S.init(MP, PW, 256, Gd - hg, bid >= hg ? bid - hg : -1);
          pg8::EpiMix<1> E{L}; pg8::gemm_phase<true>(F.lds, wid0 * 64 + pg8::fresh_lane(), F.wave, g, S, E); }
    } else if constexpr (K == 7) {
        pg8::Gemm g{(bf16*)(ws_ + WS_MC), (bf16*)(ws_ + WL + W_OUT), D, D, D, 0, MP}; pg8::StaticOrder S; S.init(MP, D, D, Gd, bid);
        constexpr int QX = I8U_ON ? 1 : 0; pg8::EpiRes<true, 8, QX> E{DRY ? 0.f : 1.f}; pg8::gemm_phase<true>(F.lds, F.tid, F.wave, g, S, E);
    }
}
#ifndef PROBE_DUP
#define PROBE_DUP -1
#endif
#define GRID_BAR() xcd_barrier_fn((unsigned*)(kargs().ws + WS_CTL), xb_xcc_id(), MISC + 8)
#if defined(XL_SEAMS)
#define SEAM_BAR(K) do { if (((K) == 1 || (K) == 2 || (K) == 5 || (K) == 6) && MISC[12] != 0u) xl_barrier_fn((unsigned*)(kargs().ws + WS_CTL), MISC + 8); else GRID_BAR(); } while (0)
#else
#define SEAM_BAR(K) GRID_BAR()
#endif
constexpr int PH_PER_LAYER = 10, PH_FIN = 1 + 2 * PH_PER_LAYER, PH_TOTAL = PH_FIN + 1;
#define PHASE(ph, L, K) if (ph_lo <= (ph) && (ph) < ph_hi) { \
    if (PROBE_DUP == (K)) { run_phase<L, K, true>(lds_raw, wid0); GRID_BAR(); } \
    run_phase<L, K, false>(lds_raw, wid0); if ((ph) + 1 < ph_hi) SEAM_BAR(K); }
#define LAYER(L) PHASE(1 + 10 * L + 0, L, 0) PHASE(1 + 10 * L + 1, L, 1) PHASE(1 + 10 * L + 2, L, 2) PHASE(1 + 10 * L + 3, L, 3) PHASE(1 + 10 * L + 4, L, 4) \
                 PHASE(1 + 10 * L + 5, L, 5) PHASE(1 + 10 * L + 6, L, 6) PHASE(1 + 10 * L + 7, L, 7) PHASE(1 + 10 * L + 8, L, 8) PHASE(1 + 10 * L + 9, L, 9)

__global__ void __launch_bounds__(512, 2) mega(Args a_) {
    extern __shared__ __attribute__((aligned(16))) unsigned char lds_raw[];
    volatile LAS unsigned* MISC = (volatile LAS unsigned*)((LAS unsigned char*)lds_raw + LDSCTL_OFF);
    if (threadIdx.x < 64) MISC[threadIdx.x] = 0u;
    __syncthreads();
    const int ph_lo = a_.ph_lo, ph_hi = a_.ph_hi; const int wid0 = __builtin_amdgcn_readfirstlane(threadIdx.x >> 6);
    if (ph_hi - ph_lo > 1 || PROBE_DUP >= 0) (void)xcd_barrier_post((unsigned*)(a_.ws + WS_CTL), MISC + 8);
    if (threadIdx.x == 0) __hip_atomic_store((unsigned*)(a_.ws + WS_CTL) + XL_TAB + blockIdx.x, xb_xcc_id(), __ATOMIC_RELAXED, __HIP_MEMORY_SCOPE_AGENT);
#if defined(I8U)
    if (ph_lo == 0) { run_phase<-1, 102, false>(lds_raw, wid0); GRID_BAR(); }
#endif
    PHASE(0, -1, 100)
#if defined(XL_SEAMS)
    if (ph_lo == 0 && ph_hi > 1) xl_census((unsigned*)(kargs().ws + WS_CTL), MISC + 8);
#endif
#if defined(PROBE_NBAR)
    for (int i_ = 0; i_ < PROBE_NBAR; ++i_) GRID_BAR();
#endif
    LAYER(0)
    LAYER(1)
    PHASE(PH_FIN, -1, 101)
}
static void launch_mega(hipStream_t stream, const Args& base, int lo, int hi, int grid) {
    Args a = base; a.ph_lo = lo; a.ph_hi = hi;
#if !defined(PLAIN_LAUNCH)
    void* kargs_[] = {&a};
    hipError_t e = hipLaunchCooperativeKernel((const void*)mega, dim3(grid), dim3(512), kargs_, LDS_BYTES, stream);
    if (e != hipSuccess) fprintf(stderr, "kernel_launch: cooperative launch failed: %s (grid %d)\n", hipGetErrorString(e), grid);
#else
    hipLaunchKernelGGL(mega, dim3(grid), dim3(512), LDS_BYTES, stream, a);
#endif
}
extern "C" void kernel_launch(void* const* d_in, const int* in_sizes, int n_in, void* d_out, int out_size, void* d_ws, size_t ws_size, hipStream_t stream) {
    static int grid = 0;
    if (grid == 0) {
        if (n_in != 31 || ws_size < WS_END) { fprintf(stderr, "kernel_launch: unexpected n_in %d / ws_size %zu (need %zu)\n", n_in, ws_size, (size_t)WS_END); grid = -1; return; }
        int dev = 0, cus = 0, per_cu = 0;
        (void)hipGetDevice(&dev); (void)hipDeviceGetAttribute(&cus, hipDeviceAttributeMultiprocessorCount, dev);
        if (hipFuncSetAttribute((const void*)mega, hipFuncAttributeMaxDynamicSharedMemorySize, LDS_BYTES) != hipSuccess) { fprintf(stderr, "kernel_launch: hipFuncSetAttribute failed\n"); grid = -1; return; }
        if (hipOccupancyMaxActiveBlocksPerMultiprocessor(&per_cu, (const void*)mega, 512, LDS_BYTES) != hipSuccess || per_cu < 1) { fprintf(stderr, "kernel_launch: occupancy query says %d blocks/CU\n", per_cu); }
        (void)hipGetLastError();
        if (cus < 256 || per_cu < 1) { fprintf(stderr, "kernel_launch: built for a 256-CU device with >= 1 resident workgroup per CU (got %d CUs, %d per CU); nothing launched\n", cus, per_cu); grid = -1; return; }
        grid = 256;
    }
    if (grid < 0) return;
    (void)hipMemsetAsync((char*)d_ws + WS_CTL, 0, CTL_ZERO_BYTES, stream);
    Args a{}; for (int i = 0; i < 31; ++i) a.in[i] = (const float*)d_in[i];
    a.out = (float*)d_out; a.ws = (unsigned char*)d_ws;
#if defined(MK_PER_PHASE)
    for (int ph = 0; ph < PH_TOTAL; ++ph) launch_mega(stream, a, ph, ph + 1, grid);
#else
    launch_mega(stream, a, 0, PH_TOTAL, grid);
#endif
}
```

```cpp
#include <hip/hip_runtime.h>
#include <cstdio>
#include <cstdint>
#include <cmath>
#define DEFER_L1 600
#define XL_SEAMS 1
#define I8U 1
namespace pg8 {
__device__ __forceinline__ int fresh_lane() { int l; asm volatile("v_mbcnt_lo_u32_b32 %0, -1, 0\n\tv_mbcnt_hi_u32_b32 %0, -1, %0" : "=v"(l)); return l; }
__device__ __forceinline__ float shfl_xor_l(float v, int mask, int lane) { return __builtin_bit_cast(float, __builtin_amdgcn_ds_bpermute((lane ^ mask) << 2, __builtin_bit_cast(int, v))); }
#define PG8_LAS __attribute__((address_space(3)))
typedef unsigned short bf16_t;
typedef short bf16x8 __attribute__((ext_vector_type(8)));
typedef float f32x4 __attribute__((ext_vector_type(4)));
typedef int i32x4 __attribute__((ext_vector_type(4)));
typedef unsigned u32x4 __attribute__((ext_vector_type(4)));
typedef unsigned u32x2 __attribute__((ext_vector_type(2)));
constexpr int BM = 256, BK = 64, HALF = 128, HTB = HALF * BK * 2  , STAGE_BYTES = 8 * HTB, NXCD = 8, WGM = 4;

__host__ __device__ __forceinline__ int lds_byte(int r, int c) { const int st = (r >> 4) * 2 + (c >> 5), rr = r & 15, cc = c & 31, ob = rr * 64 + cc * 2; return st * 1024 + (ob ^ (((ob >> 9) & 1) << 5)); }
__host__ __device__ __forceinline__ void stage_rc(int b, int& R, int& C) { const int st = b / 1024, sb = b % 1024, swz = sb ^ (((sb >> 9) & 1) << 5); R = (st >> 1) * 16 + swz / 64; C = (st & 1) * 32 + (swz % 64) / 2; }
__host__ __device__ __forceinline__ int perm32(int rho) { const int n = rho >> 4, i = rho & 15; return 8 * (i >> 2) + 4 * n + (i & 3); }

struct Unit { int pm, pn, nt; };
struct Gemm { const bf16_t* A; const bf16_t* Bt; int K, lda, ldb, a_pn_off, xrow0; };

struct StaticOrder {
    int nM, nN, nwg, G, c, ntf;
    __host__ __device__ __forceinline__ void init(int M, int N, int K, int G_, int c_) { nM = M / BM; nN = N / BM; nwg = nM * nN; G = G_; c = c_; ntf = K / BK; }
    __host__ __device__ __forceinline__ Unit next(int i) const {
        Unit u; u.pm = 0; u.pn = 0; u.nt = 0;
        const long L = (long)i * G + c; if (c < 0 || L >= nwg) return u;
        int wgid = (int)L; { const int q = nwg / NXCD, r = nwg % NXCD, xcd = wgid % NXCD, off = wgid / NXCD; wgid = (xcd < r ? xcd * (q + 1) : r * (q + 1) + (xcd - r) * q) + off; }
        const int nig = WGM * nN, gid = wgid / nig, fm = gid * WGM, gsz = (nM - fm) < WGM ? (nM - fm) : WGM;
        u.pm = fm + ((wgid % nig) % gsz); u.pn = (wgid % nig) / gsz; u.nt = ntf; return u;
    }
};

constexpr int RS_ROWS = 272, RS_STRIDE = RS_ROWS + 256;
template <int NP> __device__ __forceinline__ void rs_table(PG8_LAS float* rt, int row0, int xrow0, int tid);
template <bool RIDER, class Epi, class Sched>
__device__ __forceinline__ void gemm_phase(PG8_LAS unsigned char* lds, const int tid, const int wid, const Gemm g, const Sched& S, const Epi& E) {
    const int lane = tid & 63, wr = wid >> 2, wc = wid & 3, fr = lane & 15, fq = lane >> 4;
    unsigned voffA[2], voffB[2];
#pragma unroll
    for (int i = 0; i < 2; ++i) { int R, C; stage_rc(tid * 16 + i * 8192, R, C); const int Rb = Epi::PERM ? ((R & ~31) + perm32(R & 31)) : R;
        voffA[i] = (unsigned)(R * g.lda + C) * 2u; voffB[i] = (unsigned)(Rb * g.ldb + C) * 2u; }
    const size_t kstep = (size_t)(BK * 2);
    const size_t hstepA = (size_t)HALF * g.lda * 2, hstepB = (size_t)HALF * g.ldb * 2;
    const size_t tstepA = 2 * hstepA, tstepB = 2 * hstepB;
    const size_t pnoffA = (size_t)g.a_pn_off * 2;
    const unsigned ldsw = (unsigned)wid * 1024u;
    const int aoff = lds_byte(wr * 64 + fr, fq * 8), boff = lds_byte(wc * 32 + fr, fq * 8);
    unsigned voffX = 0; const int xoff = lds_byte(fr, fq * 8);
    if (RIDER) { int R, C; stage_rc((wid * 16 + (lane & 15)) * 16, R, C); voffX = (unsigned)(R * g.lda + C) * 2u; }
    static_assert(!RIDER || Epi::PERM, "rider phases use the permuted column order");
    PG8_LAS float* rtab = (PG8_LAS float*)(lds + STAGE_BYTES + 4096 + 1024);
#define PG8_SA(b, h) (((b) * 2 + (h)) * HTB)
#define PG8_SB(b, h) ((4 + (b) * 2 + (h)) * HTB)
#define PG8_STAGE_(bufoff, gbase, voff, aux) do { _Pragma("unroll") for (int _i = 0; _i < 2; ++_i) \
        __builtin_amdgcn_global_load_lds((const unsigned*)((const char*)(gbase) + (voff)[_i]), (PG8_LAS unsigned*)(lds + (bufoff) + ldsw + _i * 8192), 16, 0, aux); } while (0)
#define PG8_STAGE(bufoff, gbase, voff) PG8_STAGE_(bufoff, gbase, voff, 0)
#define PG8_STAGEA(bufoff, gbase, voff) PG8_STAGE_(bufoff, gbase, voff, Epi::A_AUX)
#define PG8_LDA(dst, b, h) do { _Pragma("unroll") for (int m = 0; m < 4; ++m) _Pragma("unroll") for (int k = 0; k < 2; ++k) dst[m][k] = *(const PG8_LAS bf16x8*)(lds + PG8_SA(b, h) + aoff + m * 2048 + k * 1024); } while (0)
#define PG8_LDB(dst, b, h) do { _Pragma("unroll") for (int n = 0; n < 2; ++n) _Pragma("unroll") for (int k = 0; k < 2; ++k) dst[n][k] = *(const PG8_LAS bf16x8*)(lds + PG8_SB(b, h) + boff + n * 2048 + k * 1024); } while (0)
#define PG8_MMA(ai, bj, At, Bt) do { __builtin_amdgcn_s_setprio(1); _Pragma("unroll") for (int m = 0; m < 4; ++m) _Pragma("unroll") for (int n = 0; n < 2; ++n) _Pragma("unroll") for (int k = 0; k < 2; ++k) \
        { if constexpr (Epi::I8) acc[ai][bj][m][n] = __builtin_bit_cast(f32x4, __builtin_amdgcn_mfma_i32_16x16x64_i8(__builtin_bit_cast(i32x4, Bt[n][k]), __builtin_bit_cast(i32x4, At[m][k]), __builtin_bit_cast(i32x4, acc[ai][bj][m][n]), 0, 0, 0)); \
          else acc[ai][bj][m][n] = __builtin_amdgcn_mfma_f32_16x16x32_bf16(Bt[n][k], At[m][k], acc[ai][bj][m][n], 0, 0, 0); } __builtin_amdgcn_s_setprio(0); } while (0)
#define PG8_STAGEX(b, gbase) do { if (RIDER) { if (lane < 16) __builtin_amdgcn_global_load_lds((const unsigned*)((const char*)(gbase) + voffX), (PG8_LAS unsigned*)(lds + STAGE_BYTES + (b) * 2048 + wid * 256), 16, 0, 0); } } while (0)
#define PG8_LDX(b) do { if (RIDER) { _Pragma("unroll") for (int k = 0; k < 2; ++k) Ax[k] = *(const PG8_LAS bf16x8*)(lds + STAGE_BYTES + (b) * 2048 + xoff + k * 1024); } } while (0)
#define PG8_MMAX() do { if (RIDER) { __builtin_amdgcn_s_setprio(1); if (wr == 0) { _Pragma("unroll") for (int n = 0; n < 2; ++n) _Pragma("unroll") for (int k = 0; k < 2; ++k) accx[n] = __builtin_amdgcn_mfma_f32_16x16x32_bf16(B0[n][k], Ax[k], accx[n], 0, 0, 0); } \
        else { _Pragma("unroll") for (int n = 0; n < 2; ++n) _Pragma("unroll") for (int k = 0; k < 2; ++k) accx[n] = __builtin_amdgcn_mfma_f32_16x16x32_bf16(B1[n][k], Ax[k], accx[n], 0, 0, 0); } __builtin_amdgcn_s_setprio(0); } } while (0)
#define PG8_WV(n, nr) do { if (RIDER) PG8_WAIT_V(nr); else PG8_WAIT_V(n); } while (0)
#define PG8_WAIT_V(n) asm volatile("s_waitcnt vmcnt(" #n ")" ::: "memory")
#define PG8_WAIT_L(n) asm volatile("s_waitcnt lgkmcnt(" #n ")" ::: "memory")
#define PG8_BAR __builtin_amdgcn_s_barrier()
#define PG8_SCHED __builtin_amdgcn_sched_barrier(0)
    Unit cur = S.next(0), nxt; int ui = 0;
    if (cur.nt == 0) return;
    f32x4 acc[2][2][4][2];
#pragma unroll
    for (int a = 0; a < 2; ++a)
#pragma unroll
        for (int b = 0; b < 2; ++b)
#pragma unroll
            for (int m = 0; m < 4; ++m)
#pragma unroll
                for (int n = 0; n < 2; ++n) acc[a][b][m][n] = (f32x4){0.f, 0.f, 0.f, 0.f};
    bf16x8 At[4][2], B0[2][2], B1[2][2], Ax[2]; f32x4 accx[2] = {{0.f, 0.f, 0.f, 0.f}, {0.f, 0.f, 0.f, 0.f}};
    const size_t xstep = (size_t)16 * g.lda * 2;
    const char* cA = (const char*)g.A + (size_t)cur.pm * tstepA + (size_t)cur.pn * pnoffA; const char* cB = (const char*)g.Bt + (size_t)cur.pn * tstepB;
    const char* cX = (const char*)g.A + (size_t)g.xrow0 * g.lda * 2 + (size_t)cur.pm * xstep + (size_t)cur.pn * pnoffA;
    PG8_STAGE(PG8_SB(0, 0), cB, voffB); PG8_STAGE(PG8_SB(0, 1), cB + hstepB, voffB); PG8_STAGEA(PG8_SA(0, 0), cA, voffA); PG8_STAGEX(0, cX); PG8_STAGEA(PG8_SA(0, 1), cA + hstepA, voffA);
    if constexpr (Epi::RS_NP != 0) {
        for (int i = 0; i < 8; ++i) { const Unit uu = S.next(i); if (uu.nt == 0) break; E.table(rtab + i * RS_STRIDE, uu.pm * BM, RIDER ? g.xrow0 + 16 * uu.pm : -1, tid, uu.pn); }
    }
    if (wr == 1) PG8_BAR;
    PG8_WAIT_V(2); PG8_BAR;
    PG8_STAGE(PG8_SB(1, 0), cB + kstep, voffB); PG8_STAGEA(PG8_SA(1, 0), cA + kstep, voffA); PG8_STAGE(PG8_SB(1, 1), cB + hstepB + kstep, voffB); PG8_STAGEX(1, cX + kstep);
    PG8_WV(6, 7); PG8_BAR;
    for (;;) {
        nxt = S.next(ui + 1); const bool has_next = nxt.nt != 0;
        const char* nA = has_next ? (const char*)g.A + (size_t)nxt.pm * tstepA + (size_t)nxt.pn * pnoffA : cA; const char* nB = has_next ? (const char*)g.Bt + (size_t)nxt.pn * tstepB : cB;
        const char* nX = has_next ? (const char*)g.A + (size_t)g.xrow0 * g.lda * 2 + (size_t)nxt.pm * xstep + (size_t)nxt.pn * pnoffA : cX;
        const int nt = cur.nt;
        for (int t = 0; t < nt; t += 2) {
            const bool last = (t == nt - 2);
            const char* a1 = cA + (size_t)(t + 1) * kstep;
            const char* a2 = last ? nA : cA + (size_t)(t + 2) * kstep; const char* b2 = last ? nB : cB + (size_t)(t + 2) * kstep;
            const char* a3 = a2 + kstep; const char* b3 = b2 + kstep;
            const char* x2 = last ? nX : cX + (size_t)(t + 2) * kstep; const char* x3 = x2 + kstep;
            if constexpr (Epi::MID != 0) { if (t == Epi::MID) { const int ln_ = fresh_lane(); E.mid(acc, accx, cur, wr, ln_ & 15, ln_ >> 4, ln_); } }
            PG8_LDB(B0, 0, 0); PG8_LDB(B1, 0, 1); PG8_SCHED; PG8_LDA(At, 0, 0); PG8_LDX(0); PG8_STAGEA(PG8_SA(1, 1), a1 + hstepA, voffA);
            PG8_WV(8, 9); PG8_WAIT_L(0); PG8_BAR; PG8_MMA(0, 0, At, B0); PG8_MMA(0, 1, At, B1); PG8_MMAX(); PG8_BAR; PG8_SCHED;
            PG8_LDA(At, 0, 1); PG8_STAGE(PG8_SB(0, 0), b2, voffB); PG8_STAGE(PG8_SB(0, 1), b2 + hstepB, voffB); PG8_STAGEA(PG8_SA(0, 0), a2, voffA); PG8_STAGEX(0, x2);
            PG8_WV(8, 9); PG8_WAIT_L(0); PG8_BAR; PG8_MMA(1, 0, At, B0); PG8_MMA(1, 1, At, B1); PG8_BAR; PG8_SCHED;
            PG8_LDB(B0, 1, 0); PG8_LDB(B1, 1, 1); PG8_SCHED; PG8_LDA(At, 1, 0); PG8_LDX(1); PG8_STAGEA(PG8_SA(0, 1), a2 + hstepA, voffA);
            PG8_WV(8, 9); PG8_WAIT_L(0); PG8_BAR; PG8_MMA(0, 0, At, B0); PG8_MMA(0, 1, At, B1); PG8_MMAX(); PG8_BAR; PG8_SCHED;
            PG8_LDA(At, 1, 1); PG8_STAGE(PG8_SB(1, 0), b3, voffB); PG8_STAGE(PG8_SB(1, 1), b3 + hstepB, voffB); PG8_STAGEA(PG8_SA(1, 0), a3, voffA); PG8_STAGEX(1, x3);
            PG8_WV(8, 9); PG8_WAIT_L(0); PG8_BAR; PG8_MMA(1, 0, At, B0); PG8_MMA(1, 1, At, B1); PG8_BAR; PG8_SCHED;
        }
        if (wr == 0) PG8_BAR;
        { const int ln_ = fresh_lane(); E(acc, accx, cur, wr, wc, ln_ & 15, ln_ >> 4, ln_, rtab + (ui & 7) * RS_STRIDE); }
        if (!has_next) break;
#pragma unroll
        for (int a = 0; a < 2; ++a)
#pragma unroll
            for (int b = 0; b < 2; ++b)
#pragma unroll
                for (int m = 0; m < 4; ++m)
#pragma unroll
                    for (int n = 0; n < 2; ++n) acc[a][b][m][n] = (f32x4){0.f, 0.f, 0.f, 0.f};
        accx[0] = (f32x4){0.f, 0.f, 0.f, 0.f}; accx[1] = (f32x4){0.f, 0.f, 0.f, 0.f};
        cur = nxt; cA = nA; cB = nB; cX = nX; ++ui;
        if (wr == 1) PG8_BAR;
    }
    PG8_WAIT_V(0);
    PG8_BAR;
#undef PG8_SA
#undef PG8_SB
#undef PG8_STAGE
#undef PG8_STAGE_
#undef PG8_STAGEA
#undef PG8_LDA
#undef PG8_LDB
#undef PG8_MMA
#undef PG8_STAGEX
#undef PG8_LDX
#undef PG8_MMAX
#undef PG8_WV
#undef PG8_WAIT_V
#undef PG8_WAIT_L
#undef PG8_BAR
#undef PG8_SCHED
}
}
constexpr int D = 1024, FF = 2816, DEPTH = 2;
constexpr int PB = 2, PL = 8192, SB = 16, SL = 64;
constexpr int MP = PB * PL, MS = SB * SL, M = MP + MS;
constexpr int G = 32, P = 64, H = 16, SW = 512, PW = 512, HIST = 15;
constexpr int NSC = M / 32;
constexpr float EPS = 1e-6f;

constexpr size_t MiB = 1u << 20;
constexpr size_t WS_CTL = 0, CTL_ZERO_BYTES = 192 * 1024;
constexpr size_t WS_TAB = 1 * MiB;
constexpr size_t TAB_A = 0, TAB_A32 = 32 * 1024, TAB_BB = 64 * 1024, TAB_C = TAB_BB + 256 * 1024;
constexpr size_t WS_W = 2 * MiB, W_LAYER = 38 * MiB;
constexpr size_t W_UP1 = 0, W_DN1 = 11 * MiB, W_UP2 = W_DN1 + 11 * MiB / 2, W_DN2 = W_UP2 + 11 * MiB, W_IN = W_DN2 + 11 * MiB / 2, W_OUT = W_IN + 2 * MiB, W_GLU = W_OUT + 2 * MiB, W_POOL = W_GLU + MiB / 2;
static_assert(W_POOL + MiB / 4 <= W_LAYER, "weight map");
constexpr size_t WS_XB = WS_W + 2 * W_LAYER;
constexpr size_t WS_SSQ = WS_XB + 34 * MiB;
constexpr size_t WS_SSQS = WS_SSQ + (size_t)M * 32 * 4, WS_SSQP = WS_SSQS + (size_t)M * 16 * 4;
constexpr size_t WS_E = WS_SSQ + 5 * MiB;
constexpr size_t E_BYTES = (size_t)NSC * G * P * 4;
constexpr size_t WS_PRE = WS_E + 17 * MiB;
constexpr size_t WS_H = WS_PRE + 17 * MiB;
constexpr size_t WS_U = WS_H, WS_GB = WS_H + 34 * MiB, WS_MC = WS_H + 51 * MiB;
constexpr size_t WS_END = WS_H + (size_t)M * FF * 2;
static_assert(WS_END <= 256 * MiB && WS_MC + 34 * MiB <= WS_END, "workspace map");
#if defined(I8U)
constexpr bool I8U_ON = true;
#else
constexpr bool I8U_ON = false;
#endif
constexpr size_t WS_XQ = WS_PRE, WS_QSA = WS_SSQ + 4 * MiB + MiB / 2, WS_QSB = WS_QSA + 128 * 1024;
static_assert(WS_SSQP + (size_t)M * 16 * 4 <= WS_QSA && WS_QSB + (size_t)M * 4 <= WS_E, "QS map");
constexpr size_t WS_CMAX = 64 * 1024;
constexpr float QCLIP = 6.0f, QCLIP0 = 5.0f;
struct Args { const float* in[31]; float* out; unsigned char* ws; int ph_lo, ph_hi; };
typedef const __attribute__((address_space(4))) Args* KArgsPtr;
__device__ __forceinline__ const Args& kargs() { KArgsPtr kp = (KArgsPtr)__builtin_amdgcn_kernarg_segment_ptr(); asm volatile("" : "+s"(kp)); return *(const Args*)kp; }
#ifndef A_AUX_RES
#define A_AUX_RES 0
#endif
namespace pg8 {
__device__ __forceinline__ unsigned cvt_pk_bf16(float lo, float hi) { unsigned r; asm volatile("v_cvt_pk_bf16_f32 %0, %1, %2" : "=v"(r) : "v"(lo), "v"(hi)); return r; }
__device__ __forceinline__ float bf_lo(unsigned w) { return __uint_as_float(w << 16); }
__device__ __forceinline__ float bf_hi(unsigned w) { return __uint_as_float(w & 0xffff0000u); }
__device__ __forceinline__ float fast_sigmoid(float v) { return __builtin_amdgcn_rcpf(1.0f + __builtin_amdgcn_exp2f(-1.4426950408889634f * v)); }
__device__ __forceinline__ void unpack8(float (&o)[8], const u32x4 w) { o[0] = bf_lo(w.x); o[1] = bf_hi(w.x); o[2] = bf_lo(w.y); o[3] = bf_hi(w.y); o[4] = bf_lo(w.z); o[5] = bf_hi(w.z); o[6] = bf_lo(w.w); o[7] = bf_hi(w.w); }
__device__ __forceinline__ u32x4 pack8(const float (&o)[8]) { u32x4 w; w.x = cvt_pk_bf16(o[0], o[1]); w.y = cvt_pk_bf16(o[2], o[3]); w.z = cvt_pk_bf16(o[4], o[5]); w.w = cvt_pk_bf16(o[6], o[7]); return w; }
__device__ __forceinline__ float ssq8(const u32x4 w) { float q[8]; unpack8(q, w); float s = 0.f;
#pragma unroll
    for (int e = 0; e < 8; ++e) s += q[e] * q[e];
    return s; }

__device__ __forceinline__ unsigned q8_pack4(float a, float b, float c, float d) {
    const float M_ = 12582912.0f;
    const unsigned b0 = __float_as_uint(__builtin_amdgcn_fmed3f(a, -127.f, 127.f) + M_), b1 = __float_as_uint(__builtin_amdgcn_fmed3f(b, -127.f, 127.f) + M_);
    const unsigned b2 = __float_as_uint(__builtin_amdgcn_fmed3f(c, -127.f, 127.f) + M_), b3 = __float_as_uint(__builtin_amdgcn_fmed3f(d, -127.f, 127.f) + M_);
    return __builtin_amdgcn_perm(b1, b0, 0x0c0c0400u) | __builtin_amdgcn_perm(b3, b2, 0x04000c0cu);
}
template <int NP>
__device__ __forceinline__ float row_rstd1(const float* ssq, int row, int fq, float inv_w, int lane) {
    const float* p = ssq + (size_t)row * NP + (NP / 4) * fq; float s;
    if (NP == 32) { const f32x4 a = *(const f32x4*)p, b = *(const f32x4*)(p + 4); s = ((a[0] + a[1]) + (a[2] + a[3])) + ((b[0] + b[1]) + (b[2] + b[3])); }
    else { const f32x4 a = *(const f32x4*)p; s = (a[0] + a[1]) + (a[2] + a[3]); }
    s += shfl_xor_l(s, 16, lane); s += shfl_xor_l(s, 32, lane);
    return __builtin_amdgcn_rsqf(s * inv_w + EPS);
}
template <int NP>
__device__ __forceinline__ void row_rstd(float (&rs)[2][4], const float* ssq, int row0, int fq, float inv_w, int lane) {
    float part[2][4];
#pragma unroll
    for (int ai = 0; ai < 2; ++ai)
#pragma unroll
        for (int m = 0; m < 4; ++m) { const float* p = ssq + (size_t)(row0 + ai * HALF + m * 16) * NP + (NP / 4) * fq;
            if (NP == 32) { const f32x4 a = *(const f32x4*)p, b = *(const f32x4*)(p + 4); part[ai][m] = ((a[0] + a[1]) + (a[2] + a[3])) + ((b[0] + b[1]) + (b[2] + b[3])); }
            else { const f32x4 a = *(const f32x4*)p; part[ai][m] = (a[0] + a[1]) + (a[2] + a[3]); } }
#pragma unroll
    for (int ai = 0; ai < 2; ++ai)
#pragma unroll
        for (int m = 0; m < 4; ++m) { float s = part[ai][m]; s += shfl_xor_l(s, 16, lane); s += shfl_xor_l(s, 32, lane); rs[ai][m] = __builtin_amdgcn_rsqf(s * inv_w + EPS); }
}
template <int NP, int QIN, int QOUT>
__device__ __forceinline__ void rs_table_q(PG8_LAS float* rt, int row0, int xrow0, int tid, bool qout_on) {
    unsigned char* ws = kargs().ws; const float* ssq = (const float*)(ws + WS_SSQ); const int lane = tid & 63, r = tid >> 1, hf = tid & 1;
    const float* qin = (const float*)(ws + (QIN == 1 ? WS_QSA : WS_QSB)); float* qout = (float*)(ws + (QOUT == 1 ? WS_QSA : WS_QSB));
#pragma unroll
    for (int part = 0; part < 2; ++part) {
        if (part == 1 && !(xrow0 >= 0 && tid < 32)) break;
        const int row = (part == 0 ? row0 : xrow0) + r;
        const f32x4* p = (const f32x4*)(ssq + (size_t)row * NP + hf * (NP / 2)); float s = 0.f;
#pragma unroll
        for (int j = 0; j < NP / 8; ++j) { const f32x4 a = p[j]; s += (a[0] + a[1]) + (a[2] + a[3]); }
        s += shfl_xor_l(s, 1, lane);
        if (hf == 0) { const float rv = __builtin_amdgcn_rsqf(s * (1.0f / D) + EPS); float v = rv;
            if (QIN) v = rv * qin[row] * (1.0f / 127.0f);
            if (QOUT != 0 && qout_on) qout[row] = (QCLIP / 127.0f) * __builtin_amdgcn_rcpf(rv);
            rt[(part == 0 ? 0 : BM) + r] = v; }
    }
}
template <int NP> __device__ __forceinline__ void rs_table(PG8_LAS float* rt, int row0, int xrow0, int tid) { rs_table_q<NP, 0, 0>(rt, row0, xrow0, tid, false); }
template <int QX>
__device__ __forceinline__ void qi_table(PG8_LAS float* rt, int row0, int xrow0, int tid) {
    const float* qs = (const float*)(kargs().ws + (QX == 1 ? WS_QSA : WS_QSB));
    if (tid < BM) rt[tid] = __builtin_amdgcn_rcpf(qs[row0 + tid]);
    else if (xrow0 >= 0 && tid < BM + 16) rt[tid] = __builtin_amdgcn_rcpf(qs[xrow0 + tid - BM]);
}
template <int NP>
__device__ __forceinline__ void put_ssq(float* ssq, int row, int pn, int wc, int h, bool rider, float s, int fq, int lane) {
    s += shfl_xor_l(s, 16, lane); s += shfl_xor_l(s, 32, lane);
    if (fq == 0) { float* p = ssq + (size_t)row * NP + pn * 8 + wc; if (rider) p[h * 4] = s; else { p[0] = s; p[4] = 0.f; } }
}

template <int F>
struct EpiUp {
    int l;
    static constexpr bool PERM = true, I8 = I8U_ON; static constexpr int MID = 0, A_AUX = 0, RS_NP = 32;
    __device__ __forceinline__ void table(PG8_LAS float* rt, int row0, int xrow0, int tid, int pn) const {
        if constexpr (I8) { rs_table_q<32, (F == 0 ? 2 : 1), (F == 1 ? 2 : 0)>(rt, row0, xrow0, tid, l + 1 < DEPTH);
            if (tid < 256) rt[RS_ROWS + tid] = __uint_as_float(((const unsigned*)(kargs().ws + WS_CMAX))[(l * 2 + F) * 2 * FF + (tid >> 7) * FF + pn * HALF + (tid & 127)]); }
        else rs_table<32>(rt, row0, xrow0, tid); }
    static __device__ __forceinline__ float af(float v) { if constexpr (I8) return (float)__builtin_bit_cast(int, v); else return v; }
    __device__ __forceinline__ void operator()(const f32x4 (&acc)[2][2][4][2], const f32x4 (&accx)[2], const Unit& u, int wr, int wc, int fr, int fq, int lane, const PG8_LAS float* rt) const {
        unsigned char* ws = kargs().ws; bf16_t* Hout = (bf16_t*)(ws + WS_H);
        const int row0 = u.pm * BM + wr * 64 + fr, col0 = u.pn * HALF + wc * 32 + 8 * fq;
        float rs[2][4];
#pragma unroll
        for (int ai = 0; ai < 2; ++ai)
#pragma unroll
            for (int m = 0; m < 4; ++m) rs[ai][m] = rt[ai * HALF + wr * 64 + m * 16 + fr];
        typedef float f32x2 __attribute__((ext_vector_type(2)));
        f32x2 cg[4], cu[4];
        if constexpr (I8) { const PG8_LAS f32x4* cp = (const PG8_LAS f32x4*)(rt + RS_ROWS + wc * 32 + 8 * fq); const f32x4 a0 = cp[0], a1 = cp[1], b0 = cp[32], b1 = cp[33];
            cg[0] = (f32x2){a0[0], a0[1]}; cg[1] = (f32x2){a0[2], a0[3]}; cg[2] = (f32x2){a1[0], a1[1]}; cg[3] = (f32x2){a1[2], a1[3]};
            cu[0] = (f32x2){b0[0], b0[1]}; cu[1] = (f32x2){b0[2], b0[3]}; cu[2] = (f32x2){b1[0], b1[1]}; cu[3] = (f32x2){b1[2], b1[3]}; }
#pragma unroll
        for (int ai = 0; ai < 2; ++ai)
#pragma unroll
            for (int m = 0; m < 4; ++m) { const float r = rs[ai][m], rn = -1.4426950408889634f * r, r2 = r * r; u32x4 w;
#pragma unroll
                for (int n = 0; n < 2; ++n)
#pragma unroll
                    for (int hh = 0; hh < 2; ++hh) { f32x2 gg = {af(acc[ai][0][m][n][2 * hh]), af(acc[ai][0][m][n][2 * hh + 1])}, uu = {af(acc[ai][1][m][n][2 * hh]), af(acc[ai][1][m][n][2 * hh + 1])};
                        if constexpr (I8) { gg = gg * cg[n * 2 + hh]; uu = uu * cu[n * 2 + hh]; }
                        const f32x2 t = gg * rn; f32x2 ex; ex.x = __builtin_amdgcn_exp2f(t.x); ex.y = __builtin_amdgcn_exp2f(t.y);
                        const f32x2 dn = ex + 1.0f; f32x2 rc; rc.x = __builtin_amdgcn_rcpf(dn.x); rc.y = __builtin_amdgcn_rcpf(dn.y);
                        const f32x2 hv = ((gg * uu) * r2) * rc; const unsigned pk = cvt_pk_bf16(hv.x, hv.y);
                        if (n == 0 && hh == 0) w.x = pk; else if (n == 0) w.y = pk; else if (hh == 0) w.z = pk; else w.w = pk; }
                *(u32x4*)(Hout + (size_t)(row0 + ai * HALF + m * 16) * FF + col0) = w; }
    }
};

template <bool ROWALPHA, int MIDK, int QX>
struct EpiRes {
    static constexpr bool PERM = true, I8 = false; static constexpr int MID = MIDK, A_AUX = A_AUX_RES, RS_NP = QX ? 32 : 0;
    __device__ __forceinline__ void table(PG8_LAS float* rt, int row0, int xrow0, int tid, int) const { if constexpr (QX != 0) qi_table<QX>(rt, row0, xrow0, tid); }
    float alpha;
    __device__ __forceinline__ void mid(f32x4 (&acc)[2][2][4][2], f32x4 (&accx)[2], const Unit& u, int wr, int fr, int fq, int lane) const {
        unsigned char* ws = kargs().ws; const float* ssqA = (const float*)(ws + WS_SSQS); const float* ssqB = (const float*)(ws + WS_SSQP);
        const int row0 = u.pm * BM + wr * 64 + fr;
        float ra[2][4], rb[2][4]; row_rstd<16>(ra, ssqA, row0, fq, 1.0f / SW, lane); row_rstd<16>(rb, ssqB, row0, fq, 1.0f / PW, lane);
#pragma unroll
        for (int ai = 0; ai < 2; ++ai)
#pragma unroll
            for (int m = 0; m < 4; ++m) { const float q = ra[ai][m] / rb[ai][m];
#pragma unroll
                for (int bj = 0; bj < 2; ++bj)
#pragma unroll
                    for (int n = 0; n < 2; ++n) acc[ai][bj][m][n] = acc[ai][bj][m][n] * q; }
        const int xrow = MP + 16 * u.pm + fr; const float qx = row_rstd1<16>(ssqA, xrow, fq, 1.0f / SW, lane) / row_rstd1<16>(ssqB, xrow, fq, 1.0f / PW, lane);
        accx[0] = accx[0] * qx; accx[1] = accx[1] * qx;
    }
    __device__ __forceinline__ void operator()(const f32x4 (&acc)[2][2][4][2], const f32x4 (&accx)[2], const Unit& u, int wr, int wc, int fr, int fq, int lane, const PG8_LAS float* rt) const {
        unsigned char* ws = kargs().ws; bf16_t* XB = (bf16_t*)(ws + WS_XB); float* ssq_out = (float*)(ws + WS_SSQ); const float* ssqB = (const float*)(ws + WS_SSQP);
        const int row0 = u.pm * BM + wr * 64 + fr, col0 = u.pn * BM + wc * 32 + 8 * fq;
        float al[2][4];
        if (ROWALPHA) row_rstd<16>(al, ssqB, row0, fq, 1.0f / PW, lane);
#pragma unroll
        for (int ai = 0; ai < 2; ++ai)
#pragma unroll
            for (int m = 0; m < 4; ++m) { const int row = row0 + ai * HALF + m * 16; const float a = ROWALPHA ? al[ai][m] * alpha : alpha; float s = 0.f;
                bf16_t* br = XB + (size_t)row * D + col0;
#pragma unroll
                for (int bj = 0; bj < 2; ++bj) { float xv[8], o[8]; unpack8(xv, *(const u32x4*)(br + bj * HALF));
#pragma unroll
                    for (int n = 0; n < 2; ++n)
#pragma unroll
                        for (int e = 0; e < 4; ++e) o[n * 4 + e] = xv[n * 4 + e] + acc[ai][bj][m][n][e] * a;
                    *(u32x4*)(br + bj * HALF) = pack8(o);
                    if constexpr (QX != 0) { const float qi = rt[ai * HALF + wr * 64 + m * 16 + fr];
                        *(u32x2*)(ws + WS_XQ + (size_t)row * D + col0 + bj * HALF) = (u32x2){q8_pack4(o[0] * qi, o[1] * qi, o[2] * qi, o[3] * qi), q8_pack4(o[4] * qi, o[5] * qi, o[6] * qi, o[7] * qi)}; }
#pragma unroll
                    for (int e = 0; e < 8; ++e) s += o[e] * o[e]; }
                put_ssq<32>(ssq_out, row, u.pn, wc, 0, false, s, fq, lane);
                }
        {
            const int row = MP + 16 * u.pm + fr; const float a = ROWALPHA ? row_rstd1<16>(ssqB, row, fq, 1.0f / PW, lane) * alpha : alpha;
            bf16_t* br = XB + (size_t)row * D + col0 + wr * HALF; float xv[8], o[8]; unpack8(xv, *(const u32x4*)br);
#pragma unroll
            for (int n = 0; n < 2; ++n)
#pragma unroll
                for (int e = 0; e < 4; ++e) o[n * 4 + e] = xv[n * 4 + e] + accx[n][e] * a;
            *(u32x4*)br = pack8(o); float s = 0.f;
            if constexpr (QX != 0) { const float qi = rt[BM + fr];
                *(u32x2*)(ws + WS_XQ + (size_t)row * D + col0 + wr * HALF) = (u32x2){q8_pack4(o[0] * qi, o[1] * qi, o[2] * qi, o[3] * qi), q8_pack4(o[4] * qi, o[5] * qi, o[6] * qi, o[7] * qi)}; }
#pragma unroll
            for (int e = 0; e < 8; ++e) s += o[e] * o[e];
            put_ssq<32>(ssq_out, row, u.pn, wc, wr, true, s, fq, lane);
        }
    }
};

struct EpiIn {
    static constexpr bool PERM = true, I8 = false; static constexpr int MID = 0, A_AUX = 0, RS_NP = 32;
    __device__ __forceinline__ void table(PG8_LAS float* rt, int row0, int xrow0, int tid, int) const { rs_table_q<32, 0, (I8U_ON ? 1 : 0)>(rt, row0, xrow0, tid, true); }
    __device__ __forceinline__ void operator()(const f32x4 (&acc)[2][2][4][2], const f32x4 (&accx)[2], const Unit& u, int wr, int wc, int fr, int fq, int lane, const PG8_LAS float* rt) const {
        unsigned char* ws = kargs().ws; bf16_t* U = (bf16_t*)(ws + WS_U);
        const int row0 = u.pm * BM + wr * 64 + fr, col0 = u.pn * BM + wc * 32 + 8 * fq;
        float rs[2][4];
#pragma unroll
        for (int ai = 0; ai < 2; ++ai)
#pragma unroll
            for (int m = 0; m < 4; ++m) rs[ai][m] = rt[ai * HALF + wr * 64 + m * 16 + fr];
#pragma unroll
        for (int ai = 0; ai < 2; ++ai)
#pragma unroll
            for (int m = 0; m < 4; ++m) { bf16_t* ur = U + (size_t)(row0 + ai * HALF + m * 16) * D + col0; const float r = rs[ai][m];
#pragma unroll
                for (int bj = 0; bj < 2; ++bj) { float o[8];
#pragma unroll
                    for (int n = 0; n < 2; ++n)
#pragma unroll
                        for (int e = 0; e < 4; ++e) o[n * 4 + e] = acc[ai][bj][m][n][e] * r;
                    *(u32x4*)(ur + bj * HALF) = pack8(o); } }
        { const int row = MP + 16 * u.pm + fr; const float r = rt[BM + fr]; float o[8];
#pragma unroll
          for (int n = 0; n < 2; ++n)
#pragma unroll
              for (int e = 0; e < 4; ++e) o[n * 4 + e] = accx[n][e] * r;
          *(u32x4*)(U + (size_t)row * D + col0 + wr * HALF) = pack8(o); }
    }
};

template <int MODE>
struct EpiMix {
    static constexpr bool PERM = true, I8 = false; static constexpr int MID = 0, A_AUX = 0, RS_NP = 0;
    __device__ __forceinline__ void table(PG8_LAS float*, int, int, int, int) const {}
    int l;
    __device__ __forceinline__ u32x4 one(const f32x4 a0, const f32x4 a1, const f32x4 v0, const f32x4 v1, const bf16_t* gp) const {
        float o[8];
        if (MODE == 0) { float gg[8]; unpack8(gg, *(const u32x4*)gp);
#pragma unroll
            for (int e = 0; e < 4; ++e) { o[e] = gg[e] * fast_sigmoid(a0[e] + v0[e]); o[4 + e] = gg[4 + e] * fast_sigmoid(a1[e] + v1[e]); } }
        else {
#pragma unroll
            for (int e = 0; e < 4; ++e) { o[e] = a0[e] * v0[e]; o[4 + e] = a1[e] * v1[e]; } }
        return pack8(o);
    }
    __device__ __forceinline__ void operator()(const f32x4 (&acc)[2][2][4][2], const f32x4 (&accx)[2], const Unit& u, int wr, int wc, int fr, int fq, int lane, const PG8_LAS float* rt) const {
        const Args& ka = kargs(); unsigned char* ws = ka.ws; bf16_t* MC = (bf16_t*)(ws + WS_MC) + (MODE == 1 ? SW : 0); const bf16_t* Gb = (const bf16_t*)(ws + WS_GB);
        const float* vec = (MODE == 0 ? ka.in[20] : ka.in[22]) + l * 512; float* ssq_out = (float*)(ws + (MODE == 0 ? WS_SSQS : WS_SSQP));
        const int row0 = u.pm * BM + wr * 64 + fr, col0 = u.pn * BM + wc * 32 + 8 * fq;
        f32x4 vv[2][2];
#pragma unroll
        for (int bj = 0; bj < 2; ++bj)
#pragma unroll
            for (int n = 0; n < 2; ++n) vv[bj][n] = *(const f32x4*)(vec + col0 + bj * HALF + 4 * n);
#pragma unroll
        for (int ai = 0; ai < 2; ++ai)
#pragma unroll
            for (int m = 0; m < 4; ++m) { const int row = row0 + ai * HALF + m * 16; float s = 0.f;
#pragma unroll
                for (int bj = 0; bj < 2; ++bj) { const u32x4 w = one(acc[ai][bj][m][0], acc[ai][bj][m][1], vv[bj][0], vv[bj][1], Gb + (size_t)row * SW + col0 + bj * HALF);
                    *(u32x4*)(MC + (size_t)row * D + col0 + bj * HALF) = w; s += ssq8(w); }
                put_ssq<16>(ssq_out, row, u.pn, wc, 0, false, s, fq, lane);
                }
        { const int row = MP + 16 * u.pm + fr; const int c = col0 + wr * HALF;
          const u32x4 w = one(accx[0], accx[1], wr ? vv[1][0] : vv[0][0], wr ? vv[1][1] : vv[0][1], Gb + (size_t)row * SW + c);
          *(u32x4*)(MC + (size_t)row * D + c) = w; put_ssq<16>(ssq_out, row, u.pn, wc, wr, true, ssq8(w), fq, lane); }
    }
};
}
constexpr int RING_BYTES = 131072, RIDER_BYTES = 4096, LDSCTL_OFF = RING_BYTES + RIDER_BYTES, LDS_BYTES = 155648;

typedef unsigned short bf16;
#define LAS __attribute__((address_space(3)))
typedef unsigned v4u __attribute__((ext_vector_type(4)));
typedef unsigned v2u __attribute__((ext_vector_type(2)));
typedef float f32x4 __attribute__((ext_vector_type(4)));
typedef float f32x2 __attribute__((ext_vector_type(2)));
#define LDS_WAIT() asm volatile("s_waitcnt lgkmcnt(0)" ::: "memory")
__device__ __forceinline__ unsigned f2bf(float f) { unsigned u = __builtin_bit_cast(unsigned, f); return (u + 0x7fffu + ((u >> 16) & 1u)) >> 16; }
__device__ __forceinline__ unsigned pk2(float lo, float hi) { return f2bf(lo) | (f2bf(hi) << 16); }

#define XB_TMO      128
#define XB_XCNT(j)  (256  + 64 * (j))
#define XB_XSUB(j)  (1280 + 64 * (j))
#define XB_XGEN(j)  (2304 + 64 * (j))
#define XB_TOP      3328
#define XB_TOPGEN   3392
#define XCD_BAR_WORDS 3456
#define XB_SPIN_CAP (1u << 18)
__device__ __forceinline__ unsigned xb_ld(unsigned* p)              { return __hip_atomic_load(p, __ATOMIC_RELAXED, __HIP_MEMORY_SCOPE_AGENT); }
__device__ __forceinline__ unsigned xb_add(unsigned* p, unsigned v) { return __hip_atomic_fetch_add(p, v, __ATOMIC_RELAXED, __HIP_MEMORY_SCOPE_AGENT); }
__device__ __forceinline__ unsigned xb_xcc_id() { return (unsigned)__builtin_amdgcn_s_getreg((3 << 11) | 20) & 0xFu; }
#define XB_SPIN(cond, bar) do { unsigned _sp = 0; while (cond) { __builtin_amdgcn_s_sleep(1); \
    if ((++_sp & 255u) == 0u) { if (xb_ld(&(bar)[XB_TMO])) break; if (_sp > XB_SPIN_CAP) { atomicAdd(&(bar)[XB_TMO], 1u); break; } } } } while (0)
struct XcdBarrier { unsigned* bar; unsigned x; volatile LAS unsigned* st; };
__device__ __forceinline__ XcdBarrier xcd_barrier_post(unsigned* bar, volatile LAS unsigned* st) {
    XcdBarrier b; b.bar = bar; b.x = xb_xcc_id(); b.st = st;
    if (threadIdx.x == 0) (void)xb_add(&bar[XB_XCNT(b.x)], 1u);
    return b;
}
__device__ __forceinline__ void xcd_barrier_complete(unsigned* bar, unsigned x, unsigned& nloc, unsigned& nx) {
    const unsigned Gd = gridDim.x * gridDim.y * gridDim.z;
    unsigned sum, cnt, mine, sp = 0u;
    for (;;) {
        sum = 0u; cnt = 0u; mine = 0u;
#pragma unroll
        for (unsigned j = 0; j < 16; ++j) { const unsigned c = xb_ld(&bar[XB_XCNT(j)]); sum += c; cnt += (c > 0u) ? 1u : 0u; mine = (j == x) ? c : mine; }
        if (sum == Gd) break;
        __builtin_amdgcn_s_sleep(1);
        if ((++sp & 255u) == 0u) { if (xb_ld(&bar[XB_TMO])) break; if (sp > XB_SPIN_CAP) { atomicAdd(&bar[XB_TMO], 1u); break; } }
    }
    nloc = mine > 0u ? mine : 1u; nx = cnt > 0u ? cnt : 1u;
}
__device__ __attribute__((noinline)) void xcd_barrier_fn(unsigned* bar, unsigned x, volatile LAS unsigned* st) {
    asm volatile("s_waitcnt vmcnt(0)" ::: "memory");
    __syncthreads();
    if (threadIdx.x == 0) {
        __builtin_amdgcn_s_waitcnt(0);
        unsigned nloc = st[0], nx = st[1]; const unsigned ep = st[2];
        if (nloc == 0u) { xcd_barrier_complete(bar, x, nloc, nx); st[0] = nloc; st[1] = nx; }
        st[2] = ep + 1u;
        const unsigned old = xb_add(&bar[XB_XSUB(x)], 1u);
        if (old + 1u == (ep + 1u) * nloc) {
            __builtin_amdgcn_fence(__ATOMIC_RELEASE, "agent");
            asm volatile("s_waitcnt vmcnt(0)" ::: "memory");
            const unsigned og = xb_add(&bar[XB_TOP], 1u);
            if (og + 1u == (ep + 1u) * nx) xb_add(&bar[XB_TOPGEN], 1u);
        }
        XB_SPIN(xb_ld(&bar[XB_TOPGEN]) <= ep, bar);
        __builtin_amdgcn_fence(__ATOMIC_ACQUIRE, "agent");
        asm volatile("s_waitcnt vmcnt(0)" ::: "memory");
    }
    __syncthreads();
}

#define XL_TAB   7000
#define XL_CNT(x) (7424 + 64 * (x))
__device__ __attribute__((noinline)) void xl_barrier_fn(unsigned* ctl, volatile LAS unsigned* st) {
    asm volatile("s_waitcnt vmcnt(0)" ::: "memory");
    __syncthreads();
    if (threadIdx.x == 0) {
        const unsigned ep = st[5]; st[5] = ep + 1u; const unsigned nl = gridDim.x / 8u; unsigned* cnt = ctl + XL_CNT(blockIdx.x & 7u);
        xb_add(cnt, 1u);
        XB_SPIN(xb_ld(cnt) < (ep + 1u) * nl, ctl);
        __builtin_amdgcn_fence(__ATOMIC_ACQUIRE, "agent");
        asm volatile("s_waitcnt vmcnt(0)" ::: "memory");
    }
    __syncthreads();
}
__device__ __forceinline__ void xl_census(unsigned* ctl, volatile LAS unsigned* st) {
    const int t = threadIdx.x; int ok = 1;
    if (t < (int)gridDim.x) ok = xb_ld(ctl + XL_TAB + t) == xb_ld(ctl + XL_TAB + (t & 7));
    if (t < 8 && t > 0) { for (int j = 0; j < t; ++j) ok = ok && (xb_ld(ctl + XL_TAB + t) != xb_ld(ctl + XL_TAB + j)); }
    const int all = __syncthreads_and(ok && (gridDim.x % 8u == 0u));
#if defined(XL_FORCE_OFF)
    if (t == 0) st[4] = 0u; (void)all;
#else
    if (t == 0) st[4] = all ? 1u : 0u;
#endif
    __syncthreads();
}

struct Frame {
    LAS unsigned char* lds; int tid, lane, wave, gw, NGW;
    float* out; unsigned char* ws;
};
__device__ __forceinline__ float wave_sum(float v, int lane) {
#pragma unroll
    for (int o = 1; o < 64; o <<= 1) v += pg8::shfl_xor_l(v, o, lane);
    return v;
}
constexpr int P0_PITCH = 144, P0_SCR = 64 * P0_PITCH;
struct P0Item { const float* W; const float* gain; bf16* WT; int N, ldt, k0; const unsigned* cmax; };
constexpr int P0_PER_LAYER = 6 * 704 + 2 * 256 + 64 + 16, P0_ITEMS = DEPTH * P0_PER_LAYER;
__device__ __forceinline__ P0Item p0_decode(const Args& A, unsigned char* ws, int it) {
    const int l = it / P0_PER_LAYER; int r = it % P0_PER_LAYER; bf16* wl = (bf16*)(ws + WS_W + (size_t)l * W_LAYER);
    const float* W; const float* g = nullptr; const float* ghi = nullptr; bf16* WT; int K, N, ldt, mode = 0, roff = 0, dk0 = 0, wmi = -1;
    if (r < 704) { W = A.in[6] + (size_t)l * D * FF; K = D; N = FF; g = A.in[5] + l * D; WT = wl + W_UP1 / 2; ldt = D; mode = 1; wmi = l * 2; }
    else if ((r -= 704) < 704) { W = A.in[7] + (size_t)l * D * FF; K = D; N = FF; g = A.in[5] + l * D; WT = wl + W_UP1 / 2; ldt = D; mode = 2; wmi = l * 2; }
    else if ((r -= 704) < 704) { W = A.in[8] + (size_t)l * FF * D; K = FF; N = D; WT = wl + W_DN1 / 2; ldt = FF; }
    else if ((r -= 704) < 704) { W = A.in[27] + (size_t)l * D * FF; K = D; N = FF; g = A.in[26] + l * D; WT = wl + W_UP2 / 2; ldt = D; mode = 1; wmi = l * 2 + 1; }
    else if ((r -= 704) < 704) { W = A.in[28] + (size_t)l * D * FF; K = D; N = FF; g = A.in[26] + l * D; WT = wl + W_UP2 / 2; ldt = D; mode = 2; wmi = l * 2 + 1; }
    else if ((r -= 704) < 704) { W = A.in[29] + (size_t)l * FF * D; K = FF; N = D; WT = wl + W_DN2 / 2; ldt = FF; }
    else if ((r -= 704) < 256) { W = A.in[10] + (size_t)l * D * D; K = D; N = D; g = A.in[9] + l * D; WT = wl + W_IN / 2; ldt = D; }
    else if ((r -= 256) < 256) { W = A.in[25] + (size_t)l * D * D; K = D; N = D; g = A.in[23] + l * SW; ghi = A.in[24] + l * PW; WT = wl + W_OUT / 2; ldt = D; }
    else if ((r -= 256) < 64) { W = A.in[19] + (size_t)l * SW * SW; K = SW; N = SW; WT = wl + W_GLU / 2; ldt = SW; }
    else { r -= 64; const int gi = r >> 2; r &= 3; W = A.in[21] + ((size_t)l * 4 + gi) * 128 * 128; K = 128; N = 128; WT = wl + W_POOL / 2; ldt = 256; roff = gi * 128; dk0 = (gi & 1) * 128; }
    (void)K; const int nblk = N / 64, kb = r / nblk, nb = r % nblk, k0 = 64 * kb, n0 = 64 * nb;
    const int dr = mode == 0 ? n0 : ((n0 >> 7) * 256 + (n0 & 127) + (mode == 2 ? 128 : 0));
    P0Item I; I.W = W + (size_t)k0 * N + n0; I.gain = g ? ((ghi && k0 >= 512) ? ghi + (k0 - 512) : g + k0) : nullptr; I.WT = WT + (size_t)(roff + dr) * ldt + dk0 + k0; I.N = N; I.ldt = ldt; I.k0 = k0; I.cmax = nullptr;
    if (I8U_ON && wmi >= 0) { I.WT = (bf16*)((unsigned char*)WT + (size_t)dr * D + k0); I.cmax = (const unsigned*)(ws + WS_CMAX) + wmi * 2 * FF + (mode == 2 ? FF : 0) + n0; }
    return I;
}
__device__ __forceinline__ void p0_load(const P0Item& I, f32x4 (&r0)[8], f32x4 (&r1)[8], int lane) {
    const int q = lane & 15, kp = lane >> 4;
#pragma unroll
    for (int s = 0; s < 8; ++s) { const float* wp = I.W + (size_t)(8 * s + 2 * kp) * I.N + 4 * q; r0[s] = __builtin_nontemporal_load((const f32x4*)wp); r1[s] = __builtin_nontemporal_load((const f32x4*)(wp + I.N)); }
}
__device__ __forceinline__ void p0_finish(const P0Item& I, const f32x4 (&r0)[8], const f32x4 (&r1)[8], LAS unsigned char* scr, int lane) {
    const int q = lane & 15, kp = lane >> 4;
    if (I8U_ON && I.cmax != nullptr) {
        const float M_ = 12582912.0f; float qj[4];
#pragma unroll
        for (int j = 0; j < 4; ++j) qj[j] = 127.0f / fmaxf(__uint_as_float(I.cmax[4 * q + j]), 1e-30f);
#pragma unroll
        for (int s = 0; s < 8; ++s) { const float g0 = I.gain[8 * s + 2 * kp], g1 = I.gain[8 * s + 2 * kp + 1];
#pragma unroll
            for (int j = 0; j < 4; ++j) { const unsigned b0 = __float_as_uint(__builtin_amdgcn_fmed3f(r0[s][j] * g0 * qj[j], -127.f, 127.f) + M_), b1 = __float_as_uint(__builtin_amdgcn_fmed3f(r1[s][j] * g1 * qj[j], -127.f, 127.f) + M_);
                *(LAS unsigned short*)(scr + (4 * q + j) * 80 + 8 * s + 2 * kp) = (unsigned short)((b0 & 0xffu) | ((b1 & 0xffu) << 8)); } }
        LDS_WAIT(); asm volatile("" ::: "memory");
#pragma unroll
        for (int i = 0; i < 4; ++i) { const int n = i * 16 + (lane >> 2), c = lane & 3; const v4u o = *(const LAS v4u*)(scr + n * 80 + c * 16);
            *(v4u*)((unsigned char*)I.WT + (size_t)n * D + 16 * c) = o; }
        LDS_WAIT(); asm volatile("" ::: "memory");
        return;
    }
#pragma unroll
    for (int s = 0; s < 8; ++s) { float g0 = 1.f, g1 = 1.f; if (I.gain) { g0 = I.gain[8 * s + 2 * kp]; g1 = I.gain[8 * s + 2 * kp + 1]; }
#pragma unroll
        for (int j = 0; j < 4; ++j) *(LAS unsigned*)(scr + (4 * q + j) * P0_PITCH + (4 * s + kp) * 4) = pg8::cvt_pk_bf16(r0[s][j] * g0, r1[s][j] * g1); }
    LDS_WAIT(); asm volatile("" ::: "memory");
    const int c = lane & 7;
#pragma unroll
    for (int i = 0; i < 8; ++i) { const int n = i * 8 + (lane >> 3); const v4u o = *(const LAS v4u*)(scr + n * P0_PITCH + c * 16);
        *(v4u*)(I.WT + (size_t)n * I.ldt + 8 * c) = o; }
    LDS_WAIT(); asm volatile("" ::: "memory");
}
__device__ __forceinline__ void init_row(const Frame& F, const float* src, bf16* xb, float* ssq, unsigned* xq, float* qs) {
    const f32x4* xr = (const f32x4*)src + F.lane; f32x4 v[4]; float s = 0.f; v2u w[4];
#pragma unroll
    for (int j = 0; j < 4; ++j) v[j] = __builtin_nontemporal_load(xr + 64 * j);
#pragma unroll
    for (int j = 0; j < 4; ++j) { w[j].x = pg8::cvt_pk_bf16(v[j].x, v[j].y); w[j].y = pg8::cvt_pk_bf16(v[j].z, v[j].w);
        const float a = pg8::bf_lo(w[j].x), b = pg8::bf_hi(w[j].x), c = pg8::bf_lo(w[j].y), d = pg8::bf_hi(w[j].y); s += (a * a + b * b) + (c * c + d * d); }
    s = wave_sum(s, F.lane);
#pragma unroll
    for (int j = 0; j < 4; ++j) ((v2u*)xb + F.lane)[64 * j] = w[j];
    if (F.lane < 32) ssq[F.lane] = F.lane == 0 ? s : 0.f;
    if (I8U_ON) { const float rv = __builtin_amdgcn_rsqf(s * (1.0f / D) + EPS), qi = rv * (127.0f / QCLIP0);
#pragma unroll
        for (int j = 0; j < 4; ++j) xq[F.lane + 64 * j] = pg8::q8_pack4(v[j].x * qi, v[j].y * qi, v[j].z * qi, v[j].w * qi);
        if (F.lane == 0) *qs = (QCLIP0 / 127.0f) * __builtin_amdgcn_rcpf(rv); }
}
struct S5Coef { float ar, ai, kr, ki; };
__device__ __forceinline__ S5Coef s5_coef(const Args& A, int l, int g, int p) {
    const float dt = expf(A.in[13][l * G + g]), lr = A.in[11][(l * G + g) * P + p], li = A.in[12][(l * G + g) * P + p];
    const float mag = expf(lr * dt); S5Coef c; c.ar = mag * cosf(li * dt); c.ai = mag * sinf(li * dt);
    const float den = lr * lr + li * li, nr = c.ar - 1.0f, ni = c.ai; c.kr = (nr * lr + ni * li) / den; c.ki = (ni * lr - nr * li) / den; return c;
}
typedef short bf16x8_t __attribute__((ext_vector_type(8)));
typedef float f32x16 __attribute__((ext_vector_type(16)));
constexpr int TR_PITCH = 272;
__device__ __forceinline__ float gelu_fast(float y) { const float z = 0.7978845608028654f * (y + 0.044715f * y * y * y); return y * __builtin_amdgcn_rcpf(1.0f + __builtin_amdgcn_exp2f(-2.0f * 1.4426950408889634f * z)); }

struct S5Tab { bf16x8_t tbb[4]; f32x2 a0, a1; bf16x8_t tc[4]; f32x4 dv; };
struct S5In { bf16x8_t af[2]; float hr0, hi0, hr1, hi1; v2u uw[2][2]; };
template <bool FINAL>
__device__ __forceinline__ void s5_load_tab(S5Tab& T, const Frame& F, const Args& A, const int l, const int g) {
    const unsigned char* tab = F.ws + WS_TAB; const int lane = F.lane, sg = lane & 31;
#pragma unroll
    for (int j = 0; j < 4; ++j) T.tbb[j] = ((const bf16x8_t*)(tab + TAB_BB))[((l * G + g) * 4 + j) * 64 + lane];
    T.a0 = ((const f32x2*)(tab + TAB_A))[(l * G + g) * P + sg]; T.a1 = ((const f32x2*)(tab + TAB_A))[(l * G + g) * P + sg + 32];
    if (FINAL) {
#pragma unroll
        for (int s = 0; s < 4; ++s) T.tc[s] = ((const bf16x8_t*)(tab + TAB_C))[((l * G + g) * 4 + s) * 64 + lane];
        T.dv = *(const f32x4*)(A.in[18] + (l * G + g) * H + 4 * (lane >> 4));
    }
}
template <bool FINAL>
__device__ __forceinline__ void s5_load_in(S5In& I, const Frame& F, const int row0, const int g) {
    const int lane = F.lane, sg = lane & 31, hf = lane >> 5, r = lane & 31;
    const bf16* up = (const bf16*)(F.ws + WS_U) + (size_t)(row0 + 32 * ((r >> 2) & 1) + (r & 3) + 4 * (r >> 3)) * D + g * H + 8 * hf;
    I.af[0] = *(const bf16x8_t*)up; I.af[1] = *(const bf16x8_t*)(up + (size_t)16 * D);
    I.hr0 = 0.f; I.hi0 = 0.f; I.hr1 = 0.f; I.hi1 = 0.f;
    if (FINAL) { const float* hinr = (const float*)(F.ws + WS_E + 2 * E_BYTES); const float* hini = (const float*)(F.ws + WS_E + 3 * E_BYTES);
        const size_t o = ((size_t)(row0 / 32 + hf) * G + g) * P + sg; I.hr0 = hinr[o]; I.hi0 = hini[o]; I.hr1 = hinr[o + 32]; I.hi1 = hini[o + 32];
        const int fr = lane & 15, fq = lane >> 4;
#pragma unroll
        for (int i = 0; i < 2; ++i)
#pragma unroll
            for (int rt = 0; rt < 2; ++rt) I.uw[i][rt] = *(const v2u*)((const bf16*)(F.ws + WS_U) + (size_t)(row0 + 32 * rt + 16 * i + fr) * D + g * H + 4 * fq); }
}
template <bool FINAL>
__device__ __forceinline__ void s5_unit(const Frame& F, const S5Tab& T, const S5In& I, const int row0, const int g, LAS unsigned char* tr) {
    const int lane = F.lane, sg = lane & 31, hf = lane >> 5;
    float hr0 = I.hr0, hi0 = I.hi0, hr1 = I.hr1, hi1 = I.hi1; const f32x2 a0 = T.a0, a1 = T.a1;
#pragma unroll
    for (int i = 0; i < 2; ++i) {
        const f32x16 z = {0.f, 0.f, 0.f, 0.f, 0.f, 0.f, 0.f, 0.f, 0.f, 0.f, 0.f, 0.f, 0.f, 0.f, 0.f, 0.f};
        const f32x16 x0 = __builtin_amdgcn_mfma_f32_32x32x16_bf16(I.af[i], T.tbb[0], z, 0, 0, 0);
        const f32x16 x1 = __builtin_amdgcn_mfma_f32_32x32x16_bf16(I.af[i], T.tbb[1], z, 0, 0, 0);
        const f32x16 x2 = __builtin_amdgcn_mfma_f32_32x32x16_bf16(I.af[i], T.tbb[2], z, 0, 0, 0);
        const f32x16 x3 = __builtin_amdgcn_mfma_f32_32x32x16_bf16(I.af[i], T.tbb[3], z, 0, 0, 0);
#pragma unroll
        for (int t = 0; t < 16; ++t) {
            const float n0r = __builtin_fmaf(-a0.y, hi0, __builtin_fmaf(a0.x, hr0, x0[t])), n0i = __builtin_fmaf(a0.y, hr0, __builtin_fmaf(a0.x, hi0, x2[t]));
            const float n1r = __builtin_fmaf(-a1.y, hi1, __builtin_fmaf(a1.x, hr1, x1[t])), n1i = __builtin_fmaf(a1.y, hr1, __builtin_fmaf(a1.x, hi1, x3[t]));
            hr0 = n0r; hi0 = n0i; hr1 = n1r; hi1 = n1i;
            if (FINAL) { v2u w; w.x = pg8::cvt_pk_bf16(hr0, hi0); w.y = pg8::cvt_pk_bf16(hr1, hi1); *(LAS v2u*)(tr + (hf * 16 + t) * TR_PITCH + 8 * sg) = w; }
        }
        if (FINAL) {
            const int fr = lane & 15, fq = lane >> 4;
#pragma unroll
            for (int rt = 0; rt < 2; ++rt) {
                f32x4 acc = {0.f, 0.f, 0.f, 0.f};
#pragma unroll
                for (int s = 0; s < 4; ++s) { const bf16x8_t hb = *(const LAS bf16x8_t*)(tr + (rt * 16 + fr) * TR_PITCH + s * 64 + fq * 16);
                    acc = __builtin_amdgcn_mfma_f32_16x16x32_bf16(T.tc[s], hb, acc, 0, 0, 0); }
                const int trow = row0 + 32 * rt + 16 * i + fr;
                const v2u uw = I.uw[i][rt];
                const float uv[4] = {pg8::bf_lo(uw.x), pg8::bf_hi(uw.x), pg8::bf_lo(uw.y), pg8::bf_hi(uw.y)};
                float y[4];
#pragma unroll
                for (int e = 0; e < 4; ++e) y[e] = gelu_fast(acc[e] + T.dv[e] * uv[e]);
                v2u w; w.x = pg8::cvt_pk_bf16(y[0], y[1]); w.y = pg8::cvt_pk_bf16(y[2], y[3]);
                *(v2u*)((bf16*)(F.ws + WS_GB) + (size_t)trow * SW + g * H + 4 * fq) = w;
            }
            asm volatile("s_waitcnt lgkmcnt(0)" ::: "memory");
        }
    }
    if (!FINAL) {
        float* er = (float*)(F.ws + WS_E); float* ei = (float*)(F.ws + WS_E + E_BYTES);
        const size_t o = ((size_t)(row0 / 32 + hf) * G + g) * P + sg; er[o] = hr0; ei[o] = hi0; er[o + 32] = hr1; ei[o + 32] = hi1;
    }
}
__device__ __forceinline__ int s5_chunk_of(int lu, int x) { const int cl = lu / G; return cl < 32 ? 32 * x + cl : MP / 64 + 2 * x + (cl - 32); }
template <bool FINAL>
__device__ __forceinline__ void s5_units(const Frame& F, const Args& A, const int l, LAS unsigned char* tr) {
    constexpr int NUL = 34 * G;
    const int x = blockIdx.x & 7, lw = (blockIdx.x >> 3) * 8 + F.wave, nlw = (gridDim.x >> 3) * 8;
    int it = lw; if (it >= NUL) return;
    S5Tab T; int gl = it % G; s5_load_tab<FINAL>(T, F, A, l, gl);
    S5In cur; s5_load_in<FINAL>(cur, F, s5_chunk_of(it, x) * 64, gl);
    for (;;) {
        const int nx = it + nlw; S5In nxt = cur; const int gn = nx % G;
        if (nx < NUL) s5_load_in<FINAL>(nxt, F, s5_chunk_of(nx, x) * 64, gn);
        s5_unit<FINAL>(F, T, cur, s5_chunk_of(it, x) * 64, gl, tr);
        if (nx >= NUL) break;
        if (gn != gl) { s5_load_tab<FINAL>(T, F, A, l, gn); gl = gn; }
        cur = nxt; it = nx;
    }
}

template <int W>
__device__ __forceinline__ void pool_unit(const Frame& F, const float* hist, const int sc, const int grp) {
    const int rowb = sc * 32, c = grp * 128 + 2 * F.lane; const bool prompt = rowb < MP;
    const int t0 = prompt ? (rowb & (PL - 1)) : ((rowb - MP) & (SL - 1)), strm = prompt ? 0 : (rowb - MP) / SL;
    const bf16* ucol = (const bf16*)(F.ws + WS_U) + (size_t)rowb * D + SW + c; bf16* pcol = (bf16*)(F.ws + WS_PRE) + (size_t)rowb * PW + c;
    f32x2 v[31 + W];
    if (t0 == 0) {
#pragma unroll
        for (int dt = -(W - 1); dt < 0; ++dt) v[dt + W - 1] = prompt ? (f32x2){0.f, 0.f} : *(const f32x2*)(hist + ((size_t)strm * HIST + (HIST + dt)) * PW + c);
    } else {
#pragma unroll
        for (int dt = -(W - 1); dt < 0; ++dt) { const unsigned w = *(const unsigned*)(ucol + (ptrdiff_t)dt * D); v[dt + W - 1] = (f32x2){pg8::bf_lo(w), pg8::bf_hi(w)}; }
    }
#pragma unroll
    for (int dt = 0; dt < 32; ++dt) { const unsigned w = *(const unsigned*)(ucol + (size_t)dt * D); v[dt + W - 1] = (f32x2){pg8::bf_lo(w), pg8::bf_hi(w)}; }
    f32x2 s = {0.f, 0.f};
#pragma unroll
    for (int j = 0; j < W - 1; ++j) s += v[j];
    const bool head = prompt && t0 == 0;
#pragma unroll
    for (int dt = 0; dt < 32; ++dt) {
        s += v[dt + W - 1];
        const float inv = head ? 1.0f / (float)(dt + 1 < W ? dt + 1 : W) : 1.0f / (float)W;
        const f32x2 pre = s * inv - v[dt + W - 1];
        *(unsigned*)(pcol + (size_t)dt * PW) = pg8::cvt_pk_bf16(pre.x, pre.y);
        s -= v[dt];
    }
}

template <int PART>
__device__ __forceinline__ void phase_m1(const Frame& F, const Args& A, const int l) {
    if (PART & 1) s5_units<false>(F, A, l, nullptr);
    if (!(PART & 2)) return;
    const float* hist = A.in[4] + (size_t)l * SB * HIST * PW;
    for (int it = F.gw; it < NSC * 4; it += F.NGW) {
        const int sc = it >> 2, grp = it & 3;
        if (grp == 0) pool_unit<2>(F, hist, sc, 0); else if (grp == 1) pool_unit<4>(F, hist, sc, 1); else if (grp == 2) pool_unit<8>(F, hist, sc, 2); else pool_unit<16>(F, hist, sc, 3);
    }
    float* tail_p = F.out + (size_t)M * D + 2 * DEPTH * PB * G * P + (size_t)l * PB * HIST * PW;
    float* tail_s = F.out + (size_t)M * D + 2 * DEPTH * PB * G * P + DEPTH * PB * HIST * PW + 2 * DEPTH * SB * G * P + (size_t)l * SB * HIST * PW;
    for (int it = F.gw; it < (PB + SB) * HIST; it += F.NGW) {
        const int strm = it / HIST, k = it % HIST; const bool prompt = strm < PB;
        const int row = prompt ? strm * PL + PL - HIST + k : MP + (strm - PB) * SL + SL - HIST + k;
        const v4u w = *((const v4u*)((const bf16*)(F.ws + WS_U) + (size_t)row * D + SW) + F.lane);
        f32x4* dst = (f32x4*)((prompt ? tail_p + (size_t)strm * HIST * PW : tail_s + (size_t)(strm - PB) * HIST * PW) + (size_t)k * PW) + 2 * F.lane;
        dst[0] = (f32x4){pg8::bf_lo(w.x), pg8::bf_hi(w.x), pg8::bf_lo(w.y), pg8::bf_hi(w.y)}; dst[1] = (f32x4){pg8::bf_lo(w.z), pg8::bf_hi(w.z), pg8::bf_lo(w.w), pg8::bf_hi(w.w)};
    }
}

__device__ __forceinline__ void phase_m2(const Frame& F, const Args& A, const int l, const int bid) {
    phase_m1<2>(F, A, l);
    const float* er = (const float*)(F.ws + WS_E); const float* ei = (const float*)(F.ws + WS_E + E_BYTES);
    float* hinr = (float*)(F.ws + WS_E + 2 * E_BYTES); float* hini = (float*)(F.ws + WS_E + 3 * E_BYTES);
    const unsigned char* tab = F.ws + WS_TAB;
    float* o_re_p = F.out + (size_t)M * D, *o_im_p = o_re_p + DEPTH * PB * G * P;
    float* o_re_s = o_im_p + DEPTH * PB * G * P + DEPTH * PB * HIST * PW, *o_im_s = o_re_s + DEPTH * SB * G * P;
    if (bid < 128) {
        const int b = bid >> 6, gp = (bid & 63) * 32 + (F.tid & 31), seg = F.tid >> 5;
        const f32x2 a32 = ((const f32x2*)(tab + TAB_A32))[l * G * P + gp];
        const size_t base = ((size_t)b * 256 + seg * 16) * (G * P) + gp;
        float e_r[16], e_i[16];
#pragma unroll
        for (int c = 0; c < 16; ++c) { e_r[c] = er[base + (size_t)c * (G * P)]; e_i[c] = ei[base + (size_t)c * (G * P)]; }
        float hr = 0.f, hi = 0.f;
#pragma unroll
        for (int c = 0; c < 16; ++c) { const float nr = a32.x * hr - a32.y * hi + e_r[c], ni = a32.x * hi + a32.y * hr + e_i[c]; hr = nr; hi = ni; }
        LAS f32x2* sf = (LAS f32x2*)F.lds;
        sf[seg * 32 + (F.tid & 31)] = (f32x2){hr, hi};
        float pr = a32.x, pi = a32.y;
#pragma unroll
        for (int s = 0; s < 4; ++s) { const float nr = pr * pr - pi * pi, ni = 2.0f * pr * pi; pr = nr; pi = ni; }
        __syncthreads();
        hr = 0.f; hi = 0.f;
        for (int s = 0; s < seg; ++s) { const f32x2 f = sf[s * 32 + (F.tid & 31)]; const float nr = pr * hr - pi * hi + f.x, ni = pr * hi + pi * hr + f.y; hr = nr; hi = ni; }
#pragma unroll
        for (int c = 0; c < 16; ++c) { hinr[base + (size_t)c * (G * P)] = hr; hini[base + (size_t)c * (G * P)] = hi;
            const float nr = a32.x * hr - a32.y * hi + e_r[c], ni = a32.x * hi + a32.y * hr + e_i[c]; hr = nr; hi = ni; }
        if (seg == 15) { o_re_p[((size_t)l * PB + b) * (G * P) + gp] = hr; o_im_p[((size_t)l * PB + b) * (G * P) + gp] = hi; }
        __syncthreads();
    } else {
        for (int i = (bid - 128) * 512 + F.tid; i < SB * G * P; i += 128 * 512) {
            const int s = i / (G * P), gp = i % (G * P);
            const f32x2 a32 = ((const f32x2*)(tab + TAB_A32))[l * G * P + gp];
            float hr = A.in[2][((size_t)l * SB + s) * (G * P) + gp], hi = A.in[3][((size_t)l * SB + s) * (G * P) + gp];
            const size_t base = ((size_t)(MP / 32) + 2 * s) * (G * P) + gp;
#pragma unroll
            for (int c = 0; c < 2; ++c) { hinr[base + (size_t)c * (G * P)] = hr; hini[base + (size_t)c * (G * P)] = hi;
                const float e0 = er[base + (size_t)c * (G * P)], e1 = ei[base + (size_t)c * (G * P)];
                const float nr = a32.x * hr - a32.y * hi + e0, ni = a32.x * hi + a32.y * hr + e1; hr = nr; hi = ni; }
            o_re_s[((size_t)l * SB + s) * (G * P) + gp] = hr; o_im_s[((size_t)l * SB + s) * (G * P) + gp] = hi;
        }
    }
}

__device__ __forceinline__ void phase_m3(const Frame& F, const Args& A, const int l) {
    s5_units<true>(F, A, l, F.lds + F.wave * (32 * TR_PITCH));
}

#define MIXER_M1(L) phase_m1<1>(F, a, L);
#define MIXER_M2(L) phase_m2(F, a, L, bid);
#define MIXER_M3(L) phase_m3(F, a, L);
#if defined(DEFER_L1)
constexpr int P0_DEFER = DEFER_L1;
constexpr int P0_EARLY_ITEMS = P0_ITEMS - 2 * P0_DEFER;
#else
constexpr int P0_EARLY_ITEMS = P0_ITEMS;
#endif
__device__ __forceinline__ void p0_convert(const Frame& F, const Args& A, LAS unsigned char* scr, const int lo, const int hi, const int w, const int nw) {
    int it = lo + w;
    if (it < hi) {
        P0Item cur = p0_decode(A, F.ws, it); f32x4 r0[8], r1[8]; p0_load(cur, r0, r1, F.lane);
        for (;;) {
            const int nx = it + nw; const bool more = nx < hi; P0Item nxt = cur; f32x4 n0[8], n1[8];
            if (more) { nxt = p0_decode(A, F.ws, nx); p0_load(nxt, n0, n1, F.lane); }
            p0_finish(cur, r0, r1, scr, F.lane);
            if (!more) break;
#pragma unroll
            for (int s = 0; s < 8; ++s) { r0[s] = n0[s]; r1[s] = n1[s]; }
            cur = nxt; it = nx;
        }
    }
}
__device__ __forceinline__ void phase_wmax(const Frame& F, const Args& A) {
    LAS float* red = (LAS float*)F.lds; const int nblk = F.NGW / 8, blk = F.gw / 8;
    constexpr int NCB = FF / 256, NT = 2 * DEPTH * 2 * NCB * 8;
    for (int t = blk; t < NT; t += nblk) {
        const int kc = t & 7, cb = (t >> 3) % NCB, mi = (t >> 3) / NCB, gu = mi & 1, f = (mi >> 1) & 1, l = mi >> 2;
        const float* W = A.in[f == 0 ? (gu == 0 ? 6 : 7) : (gu == 0 ? 27 : 28)] + ((size_t)l * D + kc * 128 + F.wave * 16) * FF + cb * 256 + 4 * F.lane;
        const float* gp = A.in[f == 0 ? 5 : 26] + l * D + kc * 128 + F.wave * 16;
        f32x4 v[16];
#pragma unroll
        for (int i = 0; i < 16; ++i) v[i] = *(const f32x4*)(W + (size_t)i * FF);
        f32x4 m = {0.f, 0.f, 0.f, 0.f};
#pragma unroll
        for (int i = 0; i < 16; ++i) { const float g = fabsf(gp[i]); m.x = fmaxf(m.x, fabsf(v[i].x) * g); m.y = fmaxf(m.y, fabsf(v[i].y) * g); m.z = fmaxf(m.z, fabsf(v[i].z) * g); m.w = fmaxf(m.w, fabsf(v[i].w) * g); }
        *(LAS f32x4*)(red + F.wave * 256 + 4 * F.lane) = m;
        __syncthreads();
        if (F.tid < 256) { float mx = 0.f;
#pragma unroll
            for (int w = 0; w < 8; ++w) mx = fmaxf(mx, red[w * 256 + F.tid]);
            __hip_atomic_fetch_max((unsigned*)(F.ws + WS_CMAX) + (l * 2 + f) * 2 * FF + gu * FF + cb * 256 + F.tid, __float_as_uint(mx), __ATOMIC_RELAXED, __HIP_MEMORY_SCOPE_AGENT); }
        __syncthreads();
    }
}
__device__ __forceinline__ void phase_p0(const Frame& F, const Args& A) {
    LAS unsigned char* scr = F.lds + F.wave * P0_SCR;
#define in A.in
    p0_convert(F, A, scr, 0, P0_EARLY_ITEMS, F.gw, F.NGW);
    for (int l = 0; l < DEPTH; ++l) {
        bf16* wl = (bf16*)(F.ws + WS_W + (size_t)l * W_LAYER);
        for (int i = F.gw * 64 + F.lane; i < 512 * 16; i += F.NGW * 64) { const int n = i >> 4, c = i & 15, gi = n >> 7;
            *(v4u*)(wl + W_POOL / 2 + (size_t)n * 256 + ((gi & 1) ^ 1) * 128 + c * 8) = (v4u){0u, 0u, 0u, 0u}; }
    }
    for (int m = F.gw; m < M; m += F.NGW) {
        const float* src = m < MP ? in[0] + (size_t)m * D : in[1] + (size_t)(m - MP) * D;
        init_row(F, src, (bf16*)(F.ws + WS_XB) + (size_t)m * D, (float*)(F.ws + WS_SSQ) + (size_t)m * 32, (unsigned*)(F.ws + WS_XQ + (size_t)m * D), (float*)(F.ws + WS_QSB) + m);
    }
    unsigned char* tab = F.ws + WS_TAB;
    for (int i = F.gw * 64 + F.lane; i < DEPTH * G * P; i += F.NGW * 64) {
        const int p = i % P, g = (i / P) % G, l = i / (P * G); const S5Coef c = s5_coef(A, l, g, p);
        ((f32x2*)(tab + TAB_A))[i] = (f32x2){c.ar, c.ai};
        float r = c.ar, im = c.ai;
#pragma unroll
        for (int s = 0; s < 5; ++s) { const float nr = r * r - im * im, ni = 2.0f * r * im; r = nr; im = ni; }
        ((f32x2*)(tab + TAB_A32))[i] = (f32x2){r, im};
    }
    for (int i = F.gw * 64 + F.lane; i < DEPTH * G * 4 * 64; i += F.NGW * 64) {
        const int ln = i & 63, j = (i >> 6) & 3, g = (i >> 8) % G, l = i / (256 * G);
        {
            const int c = ln & 31, hf = ln >> 5, p = 32 * (j & 1) + c; const S5Coef cf = s5_coef(A, l, g, p); float v[8];
#pragma unroll
            for (int e = 0; e < 8; ++e) { const int ch = 8 * hf + e; const float br = in[14][((size_t)(l * G + g) * P + p) * H + ch], bi = in[15][((size_t)(l * G + g) * P + p) * H + ch];
                v[e] = j < 2 ? cf.kr * br - cf.ki * bi : cf.kr * bi + cf.ki * br; }
            ((v4u*)(tab + TAB_BB))[i] = (v4u){pk2(v[0], v[1]), pk2(v[2], v[3]), pk2(v[4], v[5]), pk2(v[6], v[7])};
        }
        {
            const int ch = ln & 15, fq = ln >> 4; float v[8];
#pragma unroll
            for (int e = 0; e < 8; ++e) { const int k = 32 * j + 8 * fq + e, sg = k >> 2, comp = k & 3, p = sg + 32 * (comp >> 1);
                v[e] = (comp & 1) ? -in[17][((size_t)(l * G + g) * H + ch) * P + p] : in[16][((size_t)(l * G + g) * H + ch) * P + p]; }
            ((v4u*)(tab + TAB_C))[i] = (v4u){pk2(v[0], v[1]), pk2(v[2], v[3]), pk2(v[4], v[5]), pk2(v[6], v[7])};
        }
    }
}
#undef in
__device__ __forceinline__ void phase_fin(const Frame& F, const Args& A) {
    const float* gn = A.in[30];
    for (int m = F.gw; m < M; m += F.NGW) {
        const float* sp = (const float*)(F.ws + WS_SSQ) + (size_t)m * 32; float s = F.lane < 32 ? sp[F.lane] : 0.f; s = wave_sum(s, F.lane);
        const float r = __builtin_amdgcn_rsqf(s * (1.0f / D) + EPS);
        const v2u* xr = (const v2u*)((const bf16*)(F.ws + WS_XB) + (size_t)m * D) + F.lane; f32x4* yr = (f32x4*)(F.out + (size_t)m * D) + F.lane; const f32x4* gr = (const f32x4*)gn + F.lane;
#pragma unroll
        for (int j = 0; j < 4; ++j) { const v2u w = xr[64 * j]; const f32x4 gg = gr[64 * j];
            __builtin_nontemporal_store((f32x4){pg8::bf_lo(w.x) * r * gg.x, pg8::bf_hi(w.x) * r * gg.y, pg8::bf_lo(w.y) * r * gg.z, pg8::bf_hi(w.y) * r * gg.w}, yr + 64 * j); }
    }
}
#define PH_SETUP \
    const int tid_ = wid0 * 64 + pg8::fresh_lane(); const Args& a = kargs(); unsigned char* ws_ = a.ws; \
    Frame F; F.lds = (LAS unsigned char*)lds_raw; F.tid = tid_; F.lane = F.tid & 63; F.wave = wid0; \
    const int Gd = gridDim.x, bid = blockIdx.x; \
    { const int vcu = (Gd % 8 == 0) ? (bid % 8) * (Gd / 8) + bid / 8 : bid; F.gw = vcu * 8 + F.wave; F.NGW = Gd * 8; } \
    F.out = a.out; F.ws = ws_; (void)Gd; (void)bid;

template <int L, int K, bool DRY>
__device__ __forceinline__ void run_phase(unsigned char* lds_raw, const int wid0) {
    PH_SETUP
    constexpr size_t WL = WS_W + (size_t)(L < 0 ? 0 : L) * W_LAYER;
    if constexpr (K == 100) phase_p0(F, a);
    else if constexpr (K == 102) phase_wmax(F, a);
    else if constexpr (K == 101) phase_fin(F, a);
    else if constexpr (K == 0 || K == 8) {
        constexpr int KE = I8U_ON ? D / 2 : D;
        pg8::Gemm g{(bf16*)(ws_ + (I8U_ON ? WS_XQ : WS_XB)), (bf16*)(ws_ + WL + (K == 0 ? W_UP1 : W_UP2)), KE, KE, KE, 0, 0}; pg8::StaticOrder S; S.init(M, 2 * FF, KE, Gd, bid);
        if constexpr (K == 0) { pg8::EpiUp<0> E{L}; pg8::gemm_phase<false>(F.lds, F.tid, F.wave, g, S, E); } else { pg8::EpiUp<1> E{L}; pg8::gemm_phase<false>(F.lds, F.tid, F.wave, g, S, E); }
#if defined(DEFER_L1)
        if constexpr (L == 0 && !DRY) {
            constexpr int NT = (M / 256) * (2 * FF / 256); const int nlast = NT - (NT / Gd) * Gd, nidle = Gd - nlast;
            if (nlast > 0 && bid >= nlast) { const int lo = P0_EARLY_ITEMS + (K == 0 ? 0 : P0_DEFER), hi = lo + P0_DEFER;
                const int lane2 = pg8::fresh_lane(); Frame F2 = F; F2.lane = lane2; F2.tid = wid0 * 64 + lane2;
                p0_convert(F2, a, F.lds + F.wave * P0_SCR, lo, hi, (bid - nlast) * 8 + F.wave, nidle * 8); }
        }
#endif
    } else if constexpr (K == 1 || K == 9) {
        pg8::Gemm g{(bf16*)(ws_ + WS_H), (bf16*)(ws_ + WL + (K == 1 ? W_DN1 : W_DN2)), FF, FF, FF, 0, MP}; pg8::StaticOrder S; S.init(MP, D, FF, Gd, bid);
        if constexpr (I8U_ON && K == 9 && L + 1 < DEPTH) { pg8::EpiRes<false, 0, 2> E{DRY ? 0.f : 0.5f}; pg8::gemm_phase<true>(F.lds, F.tid, F.wave, g, S, E); }
        else { pg8::EpiRes<false, 0, 0> E{DRY ? 0.f : 0.5f}; pg8::gemm_phase<true>(F.lds, F.tid, F.wave, g, S, E); }
    } else if constexpr (K == 2) {
        pg8::Gemm g{(bf16*)(ws_ + WS_XB), (bf16*)(ws_ + WL + W_IN), D, D, D, 0, MP}; pg8::StaticOrder S; S.init(MP, D, D, Gd, bid);
        pg8::EpiIn E{}; pg8::gemm_phase<true>(F.lds, F.tid, F.wave, g, S, E);
    } else if constexpr (K == 3) { MIXER_M1(L) }
    else if constexpr (K == 4) { MIXER_M2(L) }
    else if constexpr (K == 5) { MIXER_M3(L) }
    else if constexpr (K == 6) {
        const int hg = Gd / 2;
        { pg8::Gemm g{(bf16*)(ws_ + WS_GB), (bf16*)(ws_ + WL + W_GLU), SW, SW, SW, 0, MP}; pg8::StaticOrder S; S.init(MP, SW, SW, hg, bid < hg ? bid : -1);
          pg8::EpiMix<0> E{L}; pg8::gemm_phase<true>(F.lds, F.tid, F.wave, g, S, E); }
        { pg8::Gemm g{(bf16*)(ws_ + WS_PRE), (bf16*)(ws_ + WL + W_POOL), 256, PW, 256, 256, MP}; pg8::StaticOrder S; S.init(MP, PW, 256, Gd - hg, bid >= hg ? bid - hg : -1);
          pg8::EpiMix<1> E{L}; pg8::gemm_phase<true>(F.lds, wid0 * 64 + pg8::fresh_lane(), F.wave, g, S, E); }
    } else if constexpr (K == 7) {
        pg8::Gemm g{(bf16*)(ws_ + WS_MC), (bf16*)(ws_ + WL + W_OUT), D, D, D, 0, MP}; pg8::StaticOrder S; S.init(MP, D, D, Gd, bid);
        constexpr int QX = I8U_ON ? 1 : 0; pg8::EpiRes<true, 8, QX> E{DRY ? 0.f : 1.f}; pg8::gemm_phase<true>(F.lds, F.tid, F.wave, g, S, E);
    }
}
#ifndef PROBE_DUP
#define PROBE_DUP -1
#endif
#define GRID_BAR() xcd_barrier_fn((unsigned*)(kargs().ws + WS_CTL), xb_xcc_id(), MISC + 8)
#if defined(XL_SEAMS)
#define SEAM_BAR(K) do { if (((K) == 1 || (K) == 2 || (K) == 5 || (K) == 6) && MISC[12] != 0u) xl_barrier_fn((unsigned*)(kargs().ws + WS_CTL), MISC + 8); else GRID_BAR(); } while (0)
#else
#define SEAM_BAR(K) GRID_BAR()
#endif
constexpr int PH_PER_LAYER = 10, PH_FIN = 1 + 2 * PH_PER_LAYER, PH_TOTAL = PH_FIN + 1;
#define PHASE(ph, L, K) if (ph_lo <= (ph) && (ph) < ph_hi) { \
    if (PROBE_DUP == (K)) { run_phase<L, K, true>(lds_raw, wid0); GRID_BAR(); } \
    run_phase<L, K, false>(lds_raw, wid0); if ((ph) + 1 < ph_hi) SEAM_BAR(K); }
#define LAYER(L) PHASE(1 + 10 * L + 0, L, 0) PHASE(1 + 10 * L + 1, L, 1) PHASE(1 + 10 * L + 2, L, 2) PHASE(1 + 10 * L + 3, L, 3) PHASE(1 + 10 * L + 4, L, 4) \
                 PHASE(1 + 10 * L + 5, L, 5) PHASE(1 + 10 * L + 6, L, 6) PHASE(1 + 10 * L + 7, L, 7) PHASE(1 + 10 * L + 8, L, 8) PHASE(1 + 10 * L + 9, L, 9)

__global__ void __launch_bounds__(512, 2) mega(Args a_) {
    extern __shared__ __attribute__((aligned(16))) unsigned char lds_raw[];
    volatile LAS unsigned* MISC = (volatile LAS unsigned*)((LAS unsigned char*)lds_raw + LDSCTL_OFF);
    if (threadIdx.x < 64) MISC[threadIdx.x] = 0u;
    __syncthreads();
    const int ph_lo = a_.ph_lo, ph_hi = a_.ph_hi; const int wid0 = __builtin_amdgcn_readfirstlane(threadIdx.x >> 6);
    if (ph_hi - ph_lo > 1 || PROBE_DUP >= 0) (void)xcd_barrier_post((unsigned*)(a_.ws + WS_CTL), MISC + 8);
    if (threadIdx.x == 0) __hip_atomic_store((unsigned*)(a_.ws + WS_CTL) + XL_TAB + blockIdx.x, xb_xcc_id(), __ATOMIC_RELAXED, __HIP_MEMORY_SCOPE_AGENT);
#if defined(I8U)
#if defined(PROBE_WMAX2)
    if (ph_lo == 0) { run_phase<-1, 102, false>(lds_raw, wid0); GRID_BAR(); }
#endif
    if (ph_lo == 0) { run_phase<-1, 102, false>(lds_raw, wid0); GRID_BAR(); }
#endif
    PHASE(0, -1, 100)
#if defined(XL_SEAMS)
    if (ph_lo == 0 && ph_hi > 1) xl_census((unsigned*)(kargs().ws + WS_CTL), MISC + 8);
#endif
#if defined(PROBE_NBAR)
    for (int i_ = 0; i_ < PROBE_NBAR; ++i_) GRID_BAR();
#endif
    LAYER(0)
    LAYER(1)
    PHASE(PH_FIN, -1, 101)
}
static void launch_mega(hipStream_t stream, const Args& base, int lo, int hi, int grid) {
    Args a = base; a.ph_lo = lo; a.ph_hi = hi;
#if !defined(PLAIN_LAUNCH)
    void* kargs_[] = {&a};
    hipError_t e = hipLaunchCooperativeKernel((const void*)mega, dim3(grid), dim3(512), kargs_, LDS_BYTES, stream);
    if (e != hipSuccess) fprintf(stderr, "kernel_launch: cooperative launch failed: %s (grid %d)\n", hipGetErrorString(e), grid);
#else
    hipLaunchKernelGGL(mega, dim3(grid), dim3(512), LDS_BYTES, stream, a);
#endif
}
extern "C" void kernel_launch(void* const* d_in, const int* in_sizes, int n_in, void* d_out, int out_size, void* d_ws, size_t ws_size, hipStream_t stream) {
    static int grid = 0;
    if (grid == 0) {
        if (n_in != 31 || ws_size < WS_END) { fprintf(stderr, "kernel_launch: unexpected n_in %d / ws_size %zu (need %zu)\n", n_in, ws_size, (size_t)WS_END); grid = -1; return; }
        int dev = 0, cus = 0, per_cu = 0;
        (void)hipGetDevice(&dev); (void)hipDeviceGetAttribute(&cus, hipDeviceAttributeMultiprocessorCount, dev);
        if (hipFuncSetAttribute((const void*)mega, hipFuncAttributeMaxDynamicSharedMemorySize, LDS_BYTES) != hipSuccess) { fprintf(stderr, "kernel_launch: hipFuncSetAttribute failed\n"); grid = -1; return; }
        if (hipOccupancyMaxActiveBlocksPerMultiprocessor(&per_cu, (const void*)mega, 512, LDS_BYTES) != hipSuccess || per_cu < 1) { fprintf(stderr, "kernel_launch: occupancy query says %d blocks/CU\n", per_cu); }
        (void)hipGetLastError();
        if (cus < 256 || per_cu < 1) { fprintf(stderr, "kernel_launch: built for a 256-CU device with >= 1 resident workgroup per CU (got %d CUs, %d per CU); nothing launched\n", cus, per_cu); grid = -1; return; }
        grid = 256;
    }
    if (grid < 0) return;
    (void)hipMemsetAsync((char*)d_ws + WS_CTL, 0, CTL_ZERO_BYTES, stream);
    Args a{}; for (int i = 0; i < 31; ++i) a.in[i] = (const float*)d_in[i];
    a.out = (float*)d_out; a.ws = (unsigned char*)d_ws;
#if defined(MK_PER_PHASE)
    for (int ph = 0; ph < PH_TOTAL; ++ph) launch_mega(stream, a, ph, ph + 1, grid);
#else
    launch_mega(stream, a, 0, PH_TOTAL, grid);
#endif
}
```

```cpp
#include <hip/hip_runtime.h>
#include <cstdio>
#include <cstdint>
#include <cmath>
#define DEFER_L1 600
#define XL_SEAMS 1
#define I8U 1
#define PEEL_U 1
#define XP_SEAMS 1
#define WMAX_NT 1
#define WMAX_PIPE 1
#define H_WT 1
#define P0_FUSE 1
#define P0_W2 3
#define M2_BALANCE 1
#define SCAN_BALANCE 1
#define OUT_TAB 1
#define NO_TRAIL 1
namespace pg8 {
__device__ __forceinline__ int fresh_lane() { int l; asm volatile("v_mbcnt_lo_u32_b32 %0, -1, 0\n\tv_mbcnt_hi_u32_b32 %0, -1, %0" : "=v"(l)); return l; }
__device__ __forceinline__ float shfl_xor_l(float v, int mask, int lane) { return __builtin_bit_cast(float, __builtin_amdgcn_ds_bpermute((lane ^ mask) << 2, __builtin_bit_cast(int, v))); }
#define PG8_LAS __attribute__((address_space(3)))
typedef unsigned short bf16_t;
typedef short bf16x8 __attribute__((ext_vector_type(8)));
typedef float f32x4 __attribute__((ext_vector_type(4)));
typedef int i32x4 __attribute__((ext_vector_type(4)));
typedef unsigned u32x4 __attribute__((ext_vector_type(4)));
typedef unsigned u32x2 __attribute__((ext_vector_type(2)));
constexpr int BM = 256, BK = 64, HALF = 128, HTB = HALF * BK * 2  , STAGE_BYTES = 8 * HTB, NXCD = 8, WGM = 4;

__host__ __device__ __forceinline__ int lds_byte(int r, int c) { const int st = (r >> 4) * 2 + (c >> 5), rr = r & 15, cc = c & 31, ob = rr * 64 + cc * 2; return st * 1024 + (ob ^ (((ob >> 9) & 1) << 5)); }
__host__ __device__ __forceinline__ void stage_rc(int b, int& R, int& C) { const int st = b / 1024, sb = b % 1024, swz = sb ^ (((sb >> 9) & 1) << 5); R = (st >> 1) * 16 + swz / 64; C = (st & 1) * 32 + (swz % 64) / 2; }
__host__ __device__ __forceinline__ int perm32(int rho) { const int n = rho >> 4, i = rho & 15; return 8 * (i >> 2) + 4 * n + (i & 3); }

struct Unit { int pm, pn, nt; };
struct Gemm { const bf16_t* A; const bf16_t* Bt; int K, lda, ldb, a_pn_off, xrow0; };

struct StaticOrder {
    int nM, nN, nwg, G, c, ntf;
    __host__ __device__ __forceinline__ void init(int M, int N, int K, int G_, int c_) { nM = M / BM; nN = N / BM; nwg = nM * nN; G = G_; c = c_; ntf = K / BK; }
    __host__ __device__ __forceinline__ Unit next(int i) const {
        Unit u; u.pm = 0; u.pn = 0; u.nt = 0;
        const long L = (long)i * G + c; if (c < 0 || L >= nwg) return u;
        int wgid = (int)L; { const int q = nwg / NXCD, r = nwg % NXCD, xcd = wgid % NXCD, off = wgid / NXCD; wgid = (xcd < r ? xcd * (q + 1) : r * (q + 1) + (xcd - r) * q) + off; }
        const int nig = WGM * nN, gid = wgid / nig, fm = gid * WGM, gsz = (nM - fm) < WGM ? (nM - fm) : WGM;
        u.pm = fm + ((wgid % nig) % gsz); u.pn = (wgid % nig) / gsz; u.nt = ntf; return u;
    }
};

constexpr int RS_ROWS = 272, RS_STRIDE = RS_ROWS + 256;
template <int NP> __device__ __forceinline__ void rs_table(PG8_LAS float* rt, int row0, int xrow0, int tid);
template <bool RIDER, class Epi, class Sched>
__device__ __forceinline__ void gemm_phase(PG8_LAS unsigned char* lds, const int tid, const int wid, const Gemm g, const Sched& S, const Epi& E) {
    const int lane = tid & 63, wr = wid >> 2, wc = wid & 3, fr = lane & 15, fq = lane >> 4;
    unsigned voffA[2], voffB[2];
#pragma unroll
    for (int i = 0; i < 2; ++i) { int R, C; stage_rc(tid * 16 + i * 8192, R, C); const int Rb = Epi::PERM ? ((R & ~31) + perm32(R & 31)) : R;
        voffA[i] = (unsigned)(R * g.lda + C) * 2u; voffB[i] = (unsigned)(Rb * g.ldb + C) * 2u; }
    const size_t kstep = (size_t)(BK * 2);
    const size_t hstepA = (size_t)HALF * g.lda * 2, hstepB = (size_t)HALF * g.ldb * 2;
    const size_t tstepA = 2 * hstepA, tstepB = 2 * hstepB;
    const size_t pnoffA = (size_t)g.a_pn_off * 2;
    const unsigned ldsw = (unsigned)wid * 1024u;
    const int aoff = lds_byte(wr * 64 + fr, fq * 8), boff = lds_byte(wc * 32 + fr, fq * 8);
    unsigned voffX = 0; const int xoff = lds_byte(fr, fq * 8);
    if (RIDER) { int R, C; stage_rc((wid * 16 + (lane & 15)) * 16, R, C); voffX = (unsigned)(R * g.lda + C) * 2u; }
    static_assert(!RIDER || Epi::PERM, "rider phases use the permuted column order");
    PG8_LAS float* rtab = (PG8_LAS float*)(lds + STAGE_BYTES + 4096 + 1024);
#define PG8_SA(b, h) (((b) * 2 + (h)) * HTB)
#define PG8_SB(b, h) ((4 + (b) * 2 + (h)) * HTB)
#define PG8_STAGE_(bufoff, gbase, voff, aux) do { _Pragma("unroll") for (int _i = 0; _i < 2; ++_i) \
        __builtin_amdgcn_global_load_lds((const unsigned*)((const char*)(gbase) + (voff)[_i]), (PG8_LAS unsigned*)(lds + (bufoff) + ldsw + _i * 8192), 16, 0, aux); } while (0)
#define PG8_STAGE(bufoff, gbase, voff) PG8_STAGE_(bufoff, gbase, voff, 0)
#define PG8_STAGEA(bufoff, gbase, voff) PG8_STAGE_(bufoff, gbase, voff, Epi::A_AUX)
#define PG8_LDA(dst, b, h) do { _Pragma("unroll") for (int m = 0; m < 4; ++m) _Pragma("unroll") for (int k = 0; k < 2; ++k) dst[m][k] = *(const PG8_LAS bf16x8*)(lds + PG8_SA(b, h) + aoff + m * 2048 + k * 1024); } while (0)
#define PG8_LDB(dst, b, h) do { _Pragma("unroll") for (int n = 0; n < 2; ++n) _Pragma("unroll") for (int k = 0; k < 2; ++k) dst[n][k] = *(const PG8_LAS bf16x8*)(lds + PG8_SB(b, h) + boff + n * 2048 + k * 1024); } while (0)
#define PG8_MMA(ai, bj, At, Bt) do { __builtin_amdgcn_s_setprio(1); _Pragma("unroll") for (int m = 0; m < 4; ++m) _Pragma("unroll") for (int n = 0; n < 2; ++n) _Pragma("unroll") for (int k = 0; k < 2; ++k) \
        { if constexpr (Epi::I8) acc[ai][bj][m][n] = __builtin_bit_cast(f32x4, __builtin_amdgcn_mfma_i32_16x16x64_i8(__builtin_bit_cast(i32x4, Bt[n][k]), __builtin_bit_cast(i32x4, At[m][k]), __builtin_bit_cast(i32x4, acc[ai][bj][m][n]), 0, 0, 0)); \
          else acc[ai][bj][m][n] = __builtin_amdgcn_mfma_f32_16x16x32_bf16(Bt[n][k], At[m][k], acc[ai][bj][m][n], 0, 0, 0); } __builtin_amdgcn_s_setprio(0); } while (0)
#define PG8_MMA0(ai, bj, At, Bt) do { __builtin_amdgcn_s_setprio(1); _Pragma("unroll") for (int m = 0; m < 4; ++m) _Pragma("unroll") for (int n = 0; n < 2; ++n) _Pragma("unroll") for (int k = 0; k < 2; ++k) { const f32x4 c_ = (k == 0) ? (f32x4){0.f, 0.f, 0.f, 0.f} : acc[ai][bj][m][n]; \
        { if constexpr (Epi::I8) acc[ai][bj][m][n] = __builtin_bit_cast(f32x4, __builtin_amdgcn_mfma_i32_16x16x64_i8(__builtin_bit_cast(i32x4, Bt[n][k]), __builtin_bit_cast(i32x4, At[m][k]), __builtin_bit_cast(i32x4, c_), 0, 0, 0)); \
          else acc[ai][bj][m][n] = __builtin_amdgcn_mfma_f32_16x16x32_bf16(Bt[n][k], At[m][k], c_, 0, 0, 0); } } __builtin_amdgcn_s_setprio(0); } while (0)
#define PG8_STAGEX(b, gbase) do { if (RIDER) { if (lane < 16) __builtin_amdgcn_global_load_lds((const unsigned*)((const char*)(gbase) + voffX), (PG8_LAS unsigned*)(lds + STAGE_BYTES + (b) * 2048 + wid * 256), 16, 0, 0); } } while (0)
#define PG8_LDX(b) do { if (RIDER) { _Pragma("unroll") for (int k = 0; k < 2; ++k) Ax[k] = *(const PG8_LAS bf16x8*)(lds + STAGE_BYTES + (b) * 2048 + xoff + k * 1024); } } while (0)
#define PG8_MMAX() do { if (RIDER) { __builtin_amdgcn_s_setprio(1); if (wr == 0) { _Pragma("unroll") for (int n = 0; n < 2; ++n) _Pragma("unroll") for (int k = 0; k < 2; ++k) accx[n] = __builtin_amdgcn_mfma_f32_16x16x32_bf16(B0[n][k], Ax[k], accx[n], 0, 0, 0); } \
        else { _Pragma("unroll") for (int n = 0; n < 2; ++n) _Pragma("unroll") for (int k = 0; k < 2; ++k) accx[n] = __builtin_amdgcn_mfma_f32_16x16x32_bf16(B1[n][k], Ax[k], accx[n], 0, 0, 0); } __builtin_amdgcn_s_setprio(0); } } while (0)
#define PG8_WV(n, nr) do { if (RIDER) PG8_WAIT_V(nr); else PG8_WAIT_V(n); } while (0)
#define PG8_WAIT_V(n) asm volatile("s_waitcnt vmcnt(" #n ")" ::: "memory")
#define PG8_WAIT_L(n) asm volatile("s_waitcnt lgkmcnt(" #n ")" ::: "memory")
#define PG8_BAR __builtin_amdgcn_s_barrier()
#define PG8_SCHED __builtin_amdgcn_sched_barrier(0)
    Unit cur = S.next(0), nxt; int ui = 0;
    if (cur.nt == 0) return;
    f32x4 acc[2][2][4][2];
    if constexpr (!Epi::PEEL) {
#pragma unroll
    for (int a = 0; a < 2; ++a)
#pragma unroll
        for (int b = 0; b < 2; ++b)
#pragma unroll
            for (int m = 0; m < 4; ++m)
#pragma unroll
                for (int n = 0; n < 2; ++n) acc[a][b][m][n] = (f32x4){0.f, 0.f, 0.f, 0.f};
    }
    bf16x8 At[4][2], B0[2][2], B1[2][2], Ax[2]; f32x4 accx[2] = {{0.f, 0.f, 0.f, 0.f}, {0.f, 0.f, 0.f, 0.f}};
    const size_t xstep = (size_t)16 * g.lda * 2;
    const char* cA = (const char*)g.A + (size_t)cur.pm * tstepA + (size_t)cur.pn * pnoffA; const char* cB = (const char*)g.Bt + (size_t)cur.pn * tstepB;
    const char* cX = (const char*)g.A + (size_t)g.xrow0 * g.lda * 2 + (size_t)cur.pm * xstep + (size_t)cur.pn * pnoffA;
    PG8_STAGE(PG8_SB(0, 0), cB, voffB); PG8_STAGE(PG8_SB(0, 1), cB + hstepB, voffB); PG8_STAGEA(PG8_SA(0, 0), cA, voffA); PG8_STAGEX(0, cX); PG8_STAGEA(PG8_SA(0, 1), cA + hstepA, voffA);
    if constexpr (Epi::RS_NP != 0) {
        if constexpr (Epi::TABLE_ALL) E.table_all(rtab, S, tid);
        else for (int i = 0; i < 8; ++i) { const Unit uu = S.next(i); if (uu.nt == 0) break; E.table(rtab + i * RS_STRIDE, uu.pm * BM, RIDER ? g.xrow0 + 16 * uu.pm : -1, tid, uu.pn); }
    }
    if (wr == 1) PG8_BAR;
    PG8_WAIT_V(2); PG8_BAR;
    PG8_STAGE(PG8_SB(1, 0), cB + kstep, voffB); PG8_STAGEA(PG8_SA(1, 0), cA + kstep, voffA); PG8_STAGE(PG8_SB(1, 1), cB + hstepB + kstep, voffB); PG8_STAGEX(1, cX + kstep);
    PG8_WV(6, 7); PG8_BAR;
    for (;;) {
        nxt = S.next(ui + 1); const bool has_next = nxt.nt != 0;
        const char* nA = has_next ? (const char*)g.A + (size_t)nxt.pm * tstepA + (size_t)nxt.pn * pnoffA : cA; const char* nB = has_next ? (const char*)g.Bt + (size_t)nxt.pn * tstepB : cB;
        const char* nX = has_next ? (const char*)g.A + (size_t)g.xrow0 * g.lda * 2 + (size_t)nxt.pm * xstep + (size_t)nxt.pn * pnoffA : cX;
        const int nt = cur.nt;
#define PG8_MMA_1 PG8_MMA0
#define PG8_MMA_0 PG8_MMA
#if defined(NO_TRAIL)
#define PG8_STAGE_T(bufoff, gbase, voff, aux) do { if (lane < tl) PG8_STAGE_(bufoff, gbase, voff, aux); } while (0)
#define PG8_STAGEX_T(b, gbase) do { if (RIDER) { if (lane < (tl < 16 ? tl : 16)) __builtin_amdgcn_global_load_lds((const unsigned*)((const char*)(gbase) + voffX), (PG8_LAS unsigned*)(lds + STAGE_BYTES + (b) * 2048 + wid * 256), 16, 0, 0); } } while (0)
#else
#define PG8_STAGE_T(bufoff, gbase, voff, aux) PG8_STAGE_(bufoff, gbase, voff, aux)
#define PG8_STAGEX_T(b, gbase) PG8_STAGEX(b, gbase)
#endif
#define PG8_ITER(FIRST) { \
            const bool last = (t == nt - 2); const int tl = (last && !has_next) ? 1 : 64; (void)tl; \
            const char* a1 = cA + (size_t)(t + 1) * kstep; \
            const char* a2 = last ? nA : cA + (size_t)(t + 2) * kstep; const char* b2 = last ? nB : cB + (size_t)(t + 2) * kstep; \
            const char* a3 = a2 + kstep; const char* b3 = b2 + kstep; \
            const char* x2 = last ? nX : cX + (size_t)(t + 2) * kstep; const char* x3 = x2 + kstep; \
            if constexpr (Epi::MID != 0) { if (t == Epi::MID) { const int ln_ = fresh_lane(); E.mid(acc, accx, cur, wr, ln_ & 15, ln_ >> 4, ln_, rtab + (ui & 7) * RS_STRIDE); } } \
            PG8_LDB(B0, 0, 0); PG8_LDB(B1, 0, 1); PG8_SCHED; PG8_LDA(At, 0, 0); PG8_LDX(0); PG8_STAGEA(PG8_SA(1, 1), a1 + hstepA, voffA); \
            PG8_WV(8, 9); PG8_WAIT_L(0); PG8_BAR; PG8_MMA_##FIRST(0, 0, At, B0); PG8_MMA_##FIRST(0, 1, At, B1); PG8_MMAX(); PG8_BAR; PG8_SCHED; \
            PG8_LDA(At, 0, 1); PG8_STAGE_T(PG8_SB(0, 0), b2, voffB, 0); PG8_STAGE_T(PG8_SB(0, 1), b2 + hstepB, voffB, 0); PG8_STAGE_T(PG8_SA(0, 0), a2, voffA, Epi::A_AUX); PG8_STAGEX_T(0, x2); \
            PG8_WV(8, 9); PG8_WAIT_L(0); PG8_BAR; PG8_MMA_##FIRST(1, 0, At, B0); PG8_MMA_##FIRST(1, 1, At, B1); PG8_BAR; PG8_SCHED; \
            PG8_LDB(B0, 1, 0); PG8_LDB(B1, 1, 1); PG8_SCHED; PG8_LDA(At, 1, 0); PG8_LDX(1); PG8_STAGE_T(PG8_SA(0, 1), a2 + hstepA, voffA, Epi::A_AUX); \
            PG8_WV(8, 9); PG8_WAIT_L(0); PG8_BAR; PG8_MMA(0, 0, At, B0); PG8_MMA(0, 1, At, B1); PG8_MMAX(); PG8_BAR; PG8_SCHED; \
            PG8_LDA(At, 1, 1); PG8_STAGE_T(PG8_SB(1, 0), b3, voffB, 0); PG8_STAGE_T(PG8_SB(1, 1), b3 + hstepB, voffB, 0); PG8_STAGE_T(PG8_SA(1, 0), a3, voffA, Epi::A_AUX); PG8_STAGEX_T(1, x3); \
            PG8_WV(8, 9); PG8_WAIT_L(0); PG8_BAR; PG8_MMA(1, 0, At, B0); PG8_MMA(1, 1, At, B1); PG8_BAR; PG8_SCHED; \
        }
        if constexpr (Epi::PEEL) { { const int t = 0; PG8_ITER(1) } for (int t = 2; t < nt; t += 2) PG8_ITER(0) }
        else { for (int t = 0; t < nt; t += 2) PG8_ITER(0) }
        if (wr == 0) PG8_BAR;
        { const int ln_ = fresh_lane(); E(acc, accx, cur, wr, wc, ln_ & 15, ln_ >> 4, ln_, rtab + (ui & 7) * RS_STRIDE); }
        if (!has_next) break;
        if constexpr (!Epi::PEEL) {
#pragma unroll
        for (int a = 0; a < 2; ++a)
#pragma unroll
            for (int b = 0; b < 2; ++b)
#pragma unroll
                for (int m = 0; m < 4; ++m)
#pragma unroll
                    for (int n = 0; n < 2; ++n) acc[a][b][m][n] = (f32x4){0.f, 0.f, 0.f, 0.f};
        }
        accx[0] = (f32x4){0.f, 0.f, 0.f, 0.f}; accx[1] = (f32x4){0.f, 0.f, 0.f, 0.f};
        cur = nxt; cA = nA; cB = nB; cX = nX; ++ui;
        if (wr == 1) PG8_BAR;
    }
    PG8_WAIT_V(0);
    PG8_BAR;
#undef PG8_SA
#undef PG8_SB
#undef PG8_STAGE
#undef PG8_STAGE_
#undef PG8_STAGEA
#undef PG8_LDA
#undef PG8_LDB
#undef PG8_MMA
#undef PG8_MMA0
#undef PG8_MMA_0
#undef PG8_MMA_1
#undef PG8_ITER
#undef PG8_STAGE_T
#undef PG8_STAGEX_T
#undef PG8_STAGEX
#undef PG8_LDX
#undef PG8_MMAX
#undef PG8_WV
#undef PG8_WAIT_V
#undef PG8_WAIT_L
#undef PG8_BAR
#undef PG8_SCHED
}
}
constexpr int D = 1024, FF = 2816, DEPTH = 2;
constexpr int PB = 2, PL = 8192, SB = 16, SL = 64;
constexpr int MP = PB * PL, MS = SB * SL, M = MP + MS;
constexpr int G = 32, P = 64, H = 16, SW = 512, PW = 512, HIST = 15;
constexpr int NSC = M / 32;
constexpr float EPS = 1e-6f;

constexpr size_t MiB = 1u << 20;
constexpr size_t WS_CTL = 0, CTL_ZERO_BYTES = 192 * 1024;
constexpr size_t WS_TAB = 1 * MiB;
constexpr size_t TAB_A = 0, TAB_A32 = 32 * 1024, TAB_BB = 64 * 1024, TAB_C = TAB_BB + 256 * 1024;
constexpr size_t WS_W = 2 * MiB, W_LAYER = 38 * MiB;
constexpr size_t W_UP1 = 0, W_DN1 = 11 * MiB, W_UP2 = W_DN1 + 11 * MiB / 2, W_DN2 = W_UP2 + 11 * MiB, W_IN = W_DN2 + 11 * MiB / 2, W_OUT = W_IN + 2 * MiB, W_GLU = W_OUT + 2 * MiB, W_POOL = W_GLU + MiB / 2;
static_assert(W_POOL + MiB / 4 <= W_LAYER, "weight map");
constexpr size_t WS_XB = WS_W + 2 * W_LAYER;
constexpr size_t WS_SSQ = WS_XB + 34 * MiB;
constexpr size_t WS_SSQS = WS_SSQ + (size_t)M * 32 * 4, WS_SSQP = WS_SSQS + (size_t)M * 16 * 4;
constexpr size_t WS_E = WS_SSQ + 5 * MiB;
constexpr size_t E_BYTES = (size_t)NSC * G * P * 4;
constexpr size_t WS_PRE = WS_E + 17 * MiB;
constexpr size_t WS_H = WS_PRE + 17 * MiB;
constexpr size_t WS_U = WS_H, WS_GB = WS_H + 34 * MiB, WS_MC = WS_H + 51 * MiB;
constexpr size_t WS_END = WS_H + (size_t)M * FF * 2;
static_assert(WS_END <= 256 * MiB && WS_MC + 34 * MiB <= WS_END, "workspace map");
#if defined(I8U)
constexpr bool I8U_ON = true;
#else
constexpr bool I8U_ON = false;
#endif
constexpr size_t WS_XQ = WS_PRE, WS_QSA = WS_SSQ + 4 * MiB + MiB / 2, WS_QSB = WS_QSA + 128 * 1024;
static_assert(WS_SSQP + (size_t)M * 16 * 4 <= WS_QSA && WS_QSB + (size_t)M * 4 <= WS_E, "QS map");
constexpr size_t WS_CMAX = 64 * 1024;
constexpr float QCLIP = 6.0f, QCLIP0 = 5.0f;
struct Args { const float* in[31]; float* out; unsigned char* ws; int ph_lo, ph_hi; };
typedef const __attribute__((address_space(4))) Args* KArgsPtr;
__device__ __forceinline__ const Args& kargs() { KArgsPtr kp = (KArgsPtr)__builtin_amdgcn_kernarg_segment_ptr(); asm volatile("" : "+s"(kp)); return *(const Args*)kp; }
#ifndef A_AUX_RES
#define A_AUX_RES 0
#endif
namespace pg8 {
__device__ __forceinline__ unsigned cvt_pk_bf16(float lo, float hi) { unsigned r; asm volatile("v_cvt_pk_bf16_f32 %0, %1, %2" : "=v"(r) : "v"(lo), "v"(hi)); return r; }
__device__ __forceinline__ float bf_lo(unsigned w) { return __uint_as_float(w << 16); }
__device__ __forceinline__ float bf_hi(unsigned w) { return __uint_as_float(w & 0xffff0000u); }
__device__ __forceinline__ float fast_sigmoid(float v) { return __builtin_amdgcn_rcpf(1.0f + __builtin_amdgcn_exp2f(-1.4426950408889634f * v)); }
__device__ __forceinline__ void unpack8(float (&o)[8], const u32x4 w) { o[0] = bf_lo(w.x); o[1] = bf_hi(w.x); o[2] = bf_lo(w.y); o[3] = bf_hi(w.y); o[4] = bf_lo(w.z); o[5] = bf_hi(w.z); o[6] = bf_lo(w.w); o[7] = bf_hi(w.w); }
__device__ __forceinline__ u32x4 pack8(const float (&o)[8]) { u32x4 w; w.x = cvt_pk_bf16(o[0], o[1]); w.y = cvt_pk_bf16(o[2], o[3]); w.z = cvt_pk_bf16(o[4], o[5]); w.w = cvt_pk_bf16(o[6], o[7]); return w; }
__device__ __forceinline__ float ssq8(const u32x4 w) { float q[8]; unpack8(q, w); float s = 0.f;
#pragma unroll
    for (int e = 0; e < 8; ++e) s += q[e] * q[e];
    return s; }

__device__ __forceinline__ unsigned q8_pack4(float a, float b, float c, float d) {
    const float M_ = 12582912.0f;
    const unsigned b0 = __float_as_uint(__builtin_amdgcn_fmed3f(a, -127.f, 127.f) + M_), b1 = __float_as_uint(__builtin_amdgcn_fmed3f(b, -127.f, 127.f) + M_);
    const unsigned b2 = __float_as_uint(__builtin_amdgcn_fmed3f(c, -127.f, 127.f) + M_), b3 = __float_as_uint(__builtin_amdgcn_fmed3f(d, -127.f, 127.f) + M_);
    return __builtin_amdgcn_perm(b1, b0, 0x0c0c0400u) | __builtin_amdgcn_perm(b3, b2, 0x04000c0cu);
}
template <int NP>
__device__ __forceinline__ float row_rstd1(const float* ssq, int row, int fq, float inv_w, int lane) {
    const float* p = ssq + (size_t)row * NP + (NP / 4) * fq; float s;
    if (NP == 32) { const f32x4 a = *(const f32x4*)p, b = *(const f32x4*)(p + 4); s = ((a[0] + a[1]) + (a[2] + a[3])) + ((b[0] + b[1]) + (b[2] + b[3])); }
    else { const f32x4 a = *(const f32x4*)p; s = (a[0] + a[1]) + (a[2] + a[3]); }
    s += shfl_xor_l(s, 16, lane); s += shfl_xor_l(s, 32, lane);
    return __builtin_amdgcn_rsqf(s * inv_w + EPS);
}
template <int NP>
__device__ __forceinline__ void row_rstd(float (&rs)[2][4], const float* ssq, int row0, int fq, float inv_w, int lane) {
    float part[2][4];
#pragma unroll
    for (int ai = 0; ai < 2; ++ai)
#pragma unroll
        for (int m = 0; m < 4; ++m) { const float* p = ssq + (size_t)(row0 + ai * HALF + m * 16) * NP + (NP / 4) * fq;
            if (NP == 32) { const f32x4 a = *(const f32x4*)p, b = *(const f32x4*)(p + 4); part[ai][m] = ((a[0] + a[1]) + (a[2] + a[3])) + ((b[0] + b[1]) + (b[2] + b[3])); }
            else { const f32x4 a = *(const f32x4*)p; part[ai][m] = (a[0] + a[1]) + (a[2] + a[3]); } }
#pragma unroll
    for (int ai = 0; ai < 2; ++ai)
#pragma unroll
        for (int m = 0; m < 4; ++m) { float s = part[ai][m]; s += shfl_xor_l(s, 16, lane); s += shfl_xor_l(s, 32, lane); rs[ai][m] = __builtin_amdgcn_rsqf(s * inv_w + EPS); }
}
template <int NP, int QIN, int QOUT>
__device__ __forceinline__ void rs_table_q(PG8_LAS float* rt, int row0, int xrow0, int tid, bool qout_on) {
    unsigned char* ws = kargs().ws; const float* ssq = (const float*)(ws + WS_SSQ); const int lane = tid & 63, r = tid >> 1, hf = tid & 1;
    const float* qin = (const float*)(ws + (QIN == 1 ? WS_QSA : WS_QSB)); float* qout = (float*)(ws + (QOUT == 1 ? WS_QSA : WS_QSB));
#pragma unroll
    for (int part = 0; part < 2; ++part) {
        if (part == 1 && !(xrow0 >= 0 && tid < 32)) break;
        const int row = (part == 0 ? row0 : xrow0) + r;
        const f32x4* p = (const f32x4*)(ssq + (size_t)row * NP + hf * (NP / 2)); float s = 0.f;
#pragma unroll
        for (int j = 0; j < NP / 8; ++j) { const f32x4 a = p[j]; s += (a[0] + a[1]) + (a[2] + a[3]); }
        s += shfl_xor_l(s, 1, lane);
        if (hf == 0) { const float rv = __builtin_amdgcn_rsqf(s * (1.0f / D) + EPS); float v = rv;
            if (QIN) v = rv * qin[row] * (1.0f / 127.0f);
            if (QOUT != 0 && qout_on) qout[row] = (QCLIP / 127.0f) * __builtin_amdgcn_rcpf(rv);
            rt[(part == 0 ? 0 : BM) + r] = v; }
    }
}
template <int NP> __device__ __forceinline__ void rs_table(PG8_LAS float* rt, int row0, int xrow0, int tid) { rs_table_q<NP, 0, 0>(rt, row0, xrow0, tid, false); }
#if defined(OUT_TAB)
constexpr bool OUT_TAB_ON = true;
#else
constexpr bool OUT_TAB_ON = false;
#endif
__device__ __forceinline__ void out_table(PG8_LAS float* rt, int row0, int xrow0, int tid) {
    const float* sa = (const float*)(kargs().ws + WS_SSQS); const float* sb = (const float*)(kargs().ws + WS_SSQP);
    int row = -1, sq = 0, sp = 0;
    if (tid < BM) { row = row0 + tid; sq = RS_ROWS + tid; sp = RS_STRIDE + 16 + tid; }
    else if (xrow0 >= 0 && tid < BM + 16) { row = xrow0 + tid - BM; sq = RS_STRIDE + (tid - BM); sp = RS_STRIDE + 272 + (tid - BM); }
    if (row >= 0) { const f32x4* pa = (const f32x4*)(sa + (size_t)row * 16); const f32x4* pb = (const f32x4*)(sb + (size_t)row * 16); float a = 0.f, b = 0.f;
#pragma unroll
        for (int j = 0; j < 4; ++j) { const f32x4 u = pa[j], v = pb[j]; a += (u[0] + u[1]) + (u[2] + u[3]); b += (v[0] + v[1]) + (v[2] + v[3]); }
        const float ra = __builtin_amdgcn_rsqf(a * (1.0f / SW) + EPS), rb = __builtin_amdgcn_rsqf(b * (1.0f / PW) + EPS);
        rt[sq] = ra / rb; rt[sp] = rb; }
}
template <int QX>
__device__ __forceinline__ void qi_table(PG8_LAS float* rt, int row0, int xrow0, int tid) {
    const float* qs = (const float*)(kargs().ws + (QX == 1 ? WS_QSA : WS_QSB));
    if (tid < BM) rt[tid] = __builtin_amdgcn_rcpf(qs[row0 + tid]);
    else if (xrow0 >= 0 && tid < BM + 16) rt[tid] = __builtin_amdgcn_rcpf(qs[xrow0 + tid - BM]);
}
template <int NP>
__device__ __forceinline__ void put_ssq(float* ssq, int row, int pn, int wc, int h, bool rider, float s, int fq, int lane) {
    s += shfl_xor_l(s, 16, lane); s += shfl_xor_l(s, 32, lane);
    if (fq == 0) { float* p = ssq + (size_t)row * NP + pn * 8 + wc; if (rider) p[h * 4] = s; else { p[0] = s; p[4] = 0.f; } }
}

template <int F>
struct EpiUp {
    int l;
    #if defined(PEEL_U)
    static constexpr bool PEEL = true;
#else
    static constexpr bool PEEL = false;
#endif
#if defined(TABLE_ALL_U) && defined(I8U)
    static constexpr bool TABLE_ALL = true;
#else
    static constexpr bool TABLE_ALL = false;
#endif
    static constexpr bool PERM = true, I8 = I8U_ON; static constexpr int MID = 0, A_AUX = 0, RS_NP = 32;
    __device__ __forceinline__ void table(PG8_LAS float* rt, int row0, int xrow0, int tid, int pn) const {
        if constexpr (I8) { rs_table_q<32, (F == 0 ? 2 : 1), (F == 1 ? 2 : 0)>(rt, row0, xrow0, tid, l + 1 < DEPTH);
            if (tid < 256) rt[RS_ROWS + tid] = __uint_as_float(((const unsigned*)(kargs().ws + WS_CMAX))[(l * 2 + F) * 2 * FF + (tid >> 7) * FF + pn * HALF + (tid & 127)]); }
        else rs_table<32>(rt, row0, xrow0, tid); }
    template <class Sched>
    __device__ __forceinline__ void table_all(PG8_LAS float* rtab, const Sched& S, int tid) const {
        unsigned char* ws = kargs().ws; const float* ssq = (const float*)(ws + WS_SSQ); const int half = __builtin_amdgcn_readfirstlane(tid >> 8), r = tid & 255;
        const float* qin = (const float*)(ws + (F == 0 ? WS_QSB : WS_QSA)); float* qout = (float*)(ws + WS_QSB); const bool qout_on = F == 1 && l + 1 < DEPTH;
        const unsigned* cmax = (const unsigned*)(ws + WS_CMAX) + (l * 2 + F) * 2 * FF + (r >> 7) * FF + (r & 127);
        f32x4 p[4][8]; float qv[4]; unsigned cv[4]; int row[4]; bool ok[4];
#pragma unroll
        for (int j = 0; j < 4; ++j) { const Unit u = S.next(2 * j + half); ok[j] = u.nt != 0; row[j] = u.pm * BM + r; qv[j] = 0.f; cv[j] = 0u;
            if (ok[j]) { const f32x4* sp = (const f32x4*)(ssq + (size_t)row[j] * 32);
#pragma unroll
                for (int e = 0; e < 8; ++e) p[j][e] = sp[e];
                qv[j] = qin[row[j]]; cv[j] = cmax[u.pn * HALF]; } }
#pragma unroll
        for (int j = 0; j < 4; ++j) if (ok[j]) { float s = 0.f;
#pragma unroll
            for (int e = 0; e < 8; ++e) s += (p[j][e][0] + p[j][e][1]) + (p[j][e][2] + p[j][e][3]);
            const float rv = __builtin_amdgcn_rsqf(s * (1.0f / D) + EPS); PG8_LAS float* rt = rtab + (2 * j + half) * RS_STRIDE;
            rt[r] = rv * qv[j] * (1.0f / 127.0f); rt[RS_ROWS + r] = __uint_as_float(cv[j]);
            if (qout_on) qout[row[j]] = (QCLIP / 127.0f) * __builtin_amdgcn_rcpf(rv); }
    }
    static __device__ __forceinline__ float af(float v) { if constexpr (I8) return (float)__builtin_bit_cast(int, v); else return v; }
    __device__ __forceinline__ void operator()(const f32x4 (&acc)[2][2][4][2], const f32x4 (&accx)[2], const Unit& u, int wr, int wc, int fr, int fq, int lane, const PG8_LAS float* rt) const {
        unsigned char* ws = kargs().ws; bf16_t* Hout = (bf16_t*)(ws + WS_H);
        const int row0 = u.pm * BM + wr * 64 + fr, col0 = u.pn * HALF + wc * 32 + 8 * fq;
        float rs[2][4];
#pragma unroll
        for (int ai = 0; ai < 2; ++ai)
#pragma unroll
            for (int m = 0; m < 4; ++m) rs[ai][m] = rt[ai * HALF + wr * 64 + m * 16 + fr];
        typedef float f32x2 __attribute__((ext_vector_type(2)));
        f32x2 cg[4], cu[4];
        if constexpr (I8) { const PG8_LAS f32x4* cp = (const PG8_LAS f32x4*)(rt + RS_ROWS + wc * 32 + 8 * fq); const f32x4 a0 = cp[0], a1 = cp[1], b0 = cp[32], b1 = cp[33];
            cg[0] = (f32x2){a0[0], a0[1]}; cg[1] = (f32x2){a0[2], a0[3]}; cg[2] = (f32x2){a1[0], a1[1]}; cg[3] = (f32x2){a1[2], a1[3]};
            cu[0] = (f32x2){b0[0], b0[1]}; cu[1] = (f32x2){b0[2], b0[3]}; cu[2] = (f32x2){b1[0], b1[1]}; cu[3] = (f32x2){b1[2], b1[3]}; }
#pragma unroll
        for (int ai = 0; ai < 2; ++ai)
#pragma unroll
            for (int m = 0; m < 4; ++m) { const float r = rs[ai][m], rn = -1.4426950408889634f * r, r2 = r * r; u32x4 w;
#pragma unroll
                for (int n = 0; n < 2; ++n)
#pragma unroll
                    for (int hh = 0; hh < 2; ++hh) { f32x2 gg = {af(acc[ai][0][m][n][2 * hh]), af(acc[ai][0][m][n][2 * hh + 1])}, uu = {af(acc[ai][1][m][n][2 * hh]), af(acc[ai][1][m][n][2 * hh + 1])};
                        if constexpr (I8) { gg = gg * cg[n * 2 + hh]; uu = uu * cu[n * 2 + hh]; }
                        const f32x2 t = gg * rn; f32x2 ex; ex.x = __builtin_amdgcn_exp2f(t.x); ex.y = __builtin_amdgcn_exp2f(t.y);
                        const f32x2 dn = ex + 1.0f; f32x2 rc; rc.x = __builtin_amdgcn_rcpf(dn.x); rc.y = __builtin_amdgcn_rcpf(dn.y);
                        const f32x2 hv = ((gg * uu) * r2) * rc; const unsigned pk = cvt_pk_bf16(hv.x, hv.y);
                        if (n == 0 && hh == 0) w.x = pk; else if (n == 0) w.y = pk; else if (hh == 0) w.z = pk; else w.w = pk; }
#if defined(H_WT)
                { bf16_t* hp = Hout + (size_t)(row0 + ai * HALF + m * 16) * FF + col0; asm volatile("global_store_dwordx4 %0, %1, off sc0 sc1\n\ts_nop 1" :: "v"(hp), "v"(w) : "memory"); } }
#else
                *(u32x4*)(Hout + (size_t)(row0 + ai * HALF + m * 16) * FF + col0) = w; }
#endif
    }
};

template <bool WT> __device__ __forceinline__ void st16(void* p, const u32x4 w) { if constexpr (WT) asm volatile("global_store_dwordx4 %0, %1, off sc0 sc1\n\ts_nop 1" :: "v"(p), "v"(w) : "memory"); else *(u32x4*)p = w; }
template <bool WT> __device__ __forceinline__ void st8(void* p, const u32x2 w) { if constexpr (WT) asm volatile("global_store_dwordx2 %0, %1, off sc0 sc1\n\ts_nop 1" :: "v"(p), "v"(w) : "memory"); else *(u32x2*)p = w; }
template <bool ROWALPHA, int MIDK, int QX, bool WT = false>
struct EpiRes {
    static constexpr bool PERM = true, I8 = false, PEEL = false, TABLE_ALL = false; static constexpr int MID = MIDK, A_AUX = A_AUX_RES, RS_NP = QX ? 32 : 0;
    __device__ __forceinline__ void table(PG8_LAS float* rt, int row0, int xrow0, int tid, int) const { if constexpr (QX != 0) qi_table<QX>(rt, row0, xrow0, tid); if constexpr (OUT_TAB_ON && ROWALPHA && MIDK != 0 && QX != 0) out_table(rt, row0, xrow0, tid); }
    float alpha;
    __device__ __forceinline__ void mid(f32x4 (&acc)[2][2][4][2], f32x4 (&accx)[2], const Unit& u, int wr, int fr, int fq, int lane, const PG8_LAS float* rt) const {
        if constexpr (OUT_TAB_ON && ROWALPHA && QX != 0) {
#pragma unroll
            for (int ai = 0; ai < 2; ++ai)
#pragma unroll
                for (int m = 0; m < 4; ++m) { const float q = rt[RS_ROWS + ai * HALF + wr * 64 + m * 16 + fr];
#pragma unroll
                    for (int bj = 0; bj < 2; ++bj)
#pragma unroll
                        for (int n = 0; n < 2; ++n) acc[ai][bj][m][n] = acc[ai][bj][m][n] * q; }
            const float qx = rt[RS_STRIDE + fr]; accx[0] = accx[0] * qx; accx[1] = accx[1] * qx; return;
        }
        unsigned char* ws = kargs().ws; const float* ssqA = (const float*)(ws + WS_SSQS); const float* ssqB = (const float*)(ws + WS_SSQP);
        const int row0 = u.pm * BM + wr * 64 + fr;
        float ra[2][4], rb[2][4]; row_rstd<16>(ra, ssqA, row0, fq, 1.0f / SW, lane); row_rstd<16>(rb, ssqB, row0, fq, 1.0f / PW, lane);
#pragma unroll
        for (int ai = 0; ai < 2; ++ai)
#pragma unroll
            for (int m = 0; m < 4; ++m) { const float q = ra[ai][m] / rb[ai][m];
#pragma unroll
                for (int bj = 0; bj < 2; ++bj)
#pragma unroll
                    for (int n = 0; n < 2; ++n) acc[ai][bj][m][n] = acc[ai][bj][m][n] * q; }
        const int xrow = MP + 16 * u.pm + fr; const float qx = row_rstd1<16>(ssqA, xrow, fq, 1.0f / SW, lane) / row_rstd1<16>(ssqB, xrow, fq, 1.0f / PW, lane);
        accx[0] = accx[0] * qx; accx[1] = accx[1] * qx;
    }
    __device__ __forceinline__ void operator()(const f32x4 (&acc)[2][2][4][2], const f32x4 (&accx)[2], const Unit& u, int wr, int wc, int fr, int fq, int lane, const PG8_LAS float* rt) const {
        unsigned char* ws = kargs().ws; bf16_t* XB = (bf16_t*)(ws + WS_XB); float* ssq_out = (float*)(ws + WS_SSQ); const float* ssqB = (const float*)(ws + WS_SSQP);
        const int row0 = u.pm * BM + wr * 64 + fr, col0 = u.pn * BM + wc * 32 + 8 * fq;
        float al[2][4];
        if constexpr (OUT_TAB_ON && ROWALPHA && MIDK != 0 && QX != 0) {
#pragma unroll
            for (int ai = 0; ai < 2; ++ai)
#pragma unroll
                for (int m = 0; m < 4; ++m) al[ai][m] = rt[RS_STRIDE + 16 + ai * HALF + wr * 64 + m * 16 + fr];
        } else if (ROWALPHA) row_rstd<16>(al, ssqB, row0, fq, 1.0f / PW, lane);
#pragma unroll
        for (int ai = 0; ai < 2; ++ai)
#pragma unroll
            for (int m = 0; m < 4; ++m) { const int row = row0 + ai * HALF + m * 16; const float a = ROWALPHA ? al[ai][m] * alpha : alpha; float s = 0.f;
                bf16_t* br = XB + (size_t)row * D + col0;
#pragma unroll
                for (int bj = 0; bj < 2; ++bj) { float xv[8], o[8]; unpack8(xv, *(const u32x4*)(br + bj * HALF));
#pragma unroll
                    for (int n = 0; n < 2; ++n)
#pragma unroll
                        for (int e = 0; e < 4; ++e) o[n * 4 + e] = xv[n * 4 + e] + acc[ai][bj][m][n][e] * a;
                    st16<WT>(br + bj * HALF, pack8(o));
                    if constexpr (QX != 0) { const float qi = rt[ai * HALF + wr * 64 + m * 16 + fr];
                        st8<WT>(ws + WS_XQ + (size_t)row * D + col0 + bj * HALF, (u32x2){q8_pack4(o[0] * qi, o[1] * qi, o[2] * qi, o[3] * qi), q8_pack4(o[4] * qi, o[5] * qi, o[6] * qi, o[7] * qi)}); }
#pragma unroll
                    for (int e = 0; e < 8; ++e) s += o[e] * o[e]; }
                put_ssq<32>(ssq_out, row, u.pn, wc, 0, false, s, fq, lane);
                }
        {
            const int row = MP + 16 * u.pm + fr; float a;
            if constexpr (OUT_TAB_ON && ROWALPHA && MIDK != 0 && QX != 0) a = rt[RS_STRIDE + 272 + fr] * alpha; else a = ROWALPHA ? row_rstd1<16>(ssqB, row, fq, 1.0f / PW, lane) * alpha : alpha;
            bf16_t* br = XB + (size_t)row * D + col0 + wr * HALF; float xv[8], o[8]; unpack8(xv, *(const u32x4*)br);
#pragma unroll
            for (int n = 0; n < 2; ++n)
#pragma unroll
                for (int e = 0; e < 4; ++e) o[n * 4 + e] = xv[n * 4 + e] + accx[n][e] * a;
            st16<WT>(br, pack8(o)); float s = 0.f;
            if constexpr (QX != 0) { const float qi = rt[BM + fr];
                st8<WT>(ws + WS_XQ + (size_t)row * D + col0 + wr * HALF, (u32x2){q8_pack4(o[0] * qi, o[1] * qi, o[2] * qi, o[3] * qi), q8_pack4(o[4] * qi, o[5] * qi, o[6] * qi, o[7] * qi)}); }
#pragma unroll
            for (int e = 0; e < 8; ++e) s += o[e] * o[e];
            put_ssq<32>(ssq_out, row, u.pn, wc, wr, true, s, fq, lane);
        }
    }
};

struct EpiIn {
    static constexpr bool PERM = true, I8 = false, PEEL = false, TABLE_ALL = false; static constexpr int MID = 0, A_AUX = 0, RS_NP = 32;
    __device__ __forceinline__ void table(PG8_LAS float* rt, int row0, int xrow0, int tid, int) const { rs_table_q<32, 0, (I8U_ON ? 1 : 0)>(rt, row0, xrow0, tid, true); }
    __device__ __forceinline__ void operator()(const f32x4 (&acc)[2][2][4][2], const f32x4 (&accx)[2], const Unit& u, int wr, int wc, int fr, int fq, int lane, const PG8_LAS float* rt) const {
        unsigned char* ws = kargs().ws; bf16_t* U = (bf16_t*)(ws + WS_U);
        const int row0 = u.pm * BM + wr * 64 + fr, col0 = u.pn * BM + wc * 32 + 8 * fq;
        float rs[2][4];
#pragma unroll
        for (int ai = 0; ai < 2; ++ai)
#pragma unroll
            for (int m = 0; m < 4; ++m) rs[ai][m] = rt[ai * HALF + wr * 64 + m * 16 + fr];
#pragma unroll
        for (int ai = 0; ai < 2; ++ai)
#pragma unroll
            for (int m = 0; m < 4; ++m) { bf16_t* ur = U + (size_t)(row0 + ai * HALF + m * 16) * D + col0; const float r = rs[ai][m];
#pragma unroll
                for (int bj = 0; bj < 2; ++bj) { float o[8];
#pragma unroll
                    for (int n = 0; n < 2; ++n)
#pragma unroll
                        for (int e = 0; e < 4; ++e) o[n * 4 + e] = acc[ai][bj][m][n][e] * r;
                    *(u32x4*)(ur + bj * HALF) = pack8(o); } }
        { const int row = MP + 16 * u.pm + fr; const float r = rt[BM + fr]; float o[8];
#pragma unroll
          for (int n = 0; n < 2; ++n)
#pragma unroll
              for (int e = 0; e < 4; ++e) o[n * 4 + e] = accx[n][e] * r;
          *(u32x4*)(U + (size_t)row * D + col0 + wr * HALF) = pack8(o); }
    }
};

template <int MODE>
struct EpiMix {
    static constexpr bool PERM = true, I8 = false, PEEL = false, TABLE_ALL = false; static constexpr int MID = 0, A_AUX = 0, RS_NP = 0;
    __device__ __forceinline__ void table(PG8_LAS float*, int, int, int, int) const {}
    int l;
    __device__ __forceinline__ u32x4 one(const f32x4 a0, const f32x4 a1, const f32x4 v0, const f32x4 v1, const bf16_t* gp) const {
        float o[8];
        if (MODE == 0) { float gg[8]; unpack8(gg, *(const u32x4*)gp);
#pragma unroll
            for (int e = 0; e < 4; ++e) { o[e] = gg[e] * fast_sigmoid(a0[e] + v0[e]); o[4 + e] = gg[4 + e] * fast_sigmoid(a1[e] + v1[e]); } }
        else {
#pragma unroll
            for (int e = 0; e < 4; ++e) { o[e] = a0[e] * v0[e]; o[4 + e] = a1[e] * v1[e]; } }
        return pack8(o);
    }
    __device__ __forceinline__ void operator()(const f32x4 (&acc)[2][2][4][2], const f32x4 (&accx)[2], const Unit& u, int wr, int wc, int fr, int fq, int lane, const PG8_LAS float* rt) const {
        const Args& ka = kargs(); unsigned char* ws = ka.ws; bf16_t* MC = (bf16_t*)(ws + WS_MC) + (MODE == 1 ? SW : 0); const bf16_t* Gb = (const bf16_t*)(ws + WS_GB);
        const float* vec = (MODE == 0 ? ka.in[20] : ka.in[22]) + l * 512; float* ssq_out = (float*)(ws + (MODE == 0 ? WS_SSQS : WS_SSQP));
        const int row0 = u.pm * BM + wr * 64 + fr, col0 = u.pn * BM + wc * 32 + 8 * fq;
        f32x4 vv[2][2];
#pragma unroll
        for (int bj = 0; bj < 2; ++bj)
#pragma unroll
            for (int n = 0; n < 2; ++n) vv[bj][n] = *(const f32x4*)(vec + col0 + bj * HALF + 4 * n);
#pragma unroll
        for (int ai = 0; ai < 2; ++ai)
#pragma unroll
            for (int m = 0; m < 4; ++m) { const int row = row0 + ai * HALF + m * 16; float s = 0.f;
#pragma unroll
                for (int bj = 0; bj < 2; ++bj) { const u32x4 w = one(acc[ai][bj][m][0], acc[ai][bj][m][1], vv[bj][0], vv[bj][1], Gb + (size_t)row * SW + col0 + bj * HALF);
                    *(u32x4*)(MC + (size_t)row * D + col0 + bj * HALF) = w; s += ssq8(w); }
                put_ssq<16>(ssq_out, row, u.pn, wc, 0, false, s, fq, lane);
                }
        { const int row = MP + 16 * u.pm + fr; const int c = col0 + wr * HALF;
          const u32x4 w = one(accx[0], accx[1], wr ? vv[1][0] : vv[0][0], wr ? vv[1][1] : vv[0][1], Gb + (size_t)row * SW + c);
          *(u32x4*)(MC + (size_t)row * D + c) = w; put_ssq<16>(ssq_out, row, u.pn, wc, wr, true, ssq8(w), fq, lane); }
    }
};
}
constexpr int RING_BYTES = 131072, RIDER_BYTES = 4096, LDSCTL_OFF = RING_BYTES + RIDER_BYTES, LDS_BYTES = 155648;

typedef unsigned short bf16;
#define LAS __attribute__((address_space(3)))
typedef unsigned v4u __attribute__((ext_vector_type(4)));
typedef unsigned v2u __attribute__((ext_vector_type(2)));
typedef float f32x4 __attribute__((ext_vector_type(4)));
typedef float f32x2 __attribute__((ext_vector_type(2)));
#define LDS_WAIT() asm volatile("s_waitcnt lgkmcnt(0)" ::: "memory")
__device__ __forceinline__ unsigned f2bf(float f) { unsigned u = __builtin_bit_cast(unsigned, f); return (u + 0x7fffu + ((u >> 16) & 1u)) >> 16; }
__device__ __forceinline__ unsigned pk2(float lo, float hi) { return f2bf(lo) | (f2bf(hi) << 16); }

#define XB_TMO      128
#define XB_XCNT(j)  (256  + 64 * (j))
#define XB_XSUB(j)  (1280 + 64 * (j))
#define XB_XGEN(j)  (2304 + 64 * (j))
#define XB_TOP      3328
#define XB_TOPGEN   3392
#define XCD_BAR_WORDS 3456
#define XB_SPIN_CAP (1u << 18)
__device__ __forceinline__ unsigned xb_ld(unsigned* p)              { return __hip_atomic_load(p, __ATOMIC_RELAXED, __HIP_MEMORY_SCOPE_AGENT); }
__device__ __forceinline__ unsigned xb_add(unsigned* p, unsigned v) { return __hip_atomic_fetch_add(p, v, __ATOMIC_RELAXED, __HIP_MEMORY_SCOPE_AGENT); }
__device__ __forceinline__ unsigned xb_xcc_id() { return (unsigned)__builtin_amdgcn_s_getreg((3 << 11) | 20) & 0xFu; }
#define XB_SPIN(cond, bar) do { unsigned _sp = 0; while (cond) { __builtin_amdgcn_s_sleep(1); \
    if ((++_sp & 255u) == 0u) { if (xb_ld(&(bar)[XB_TMO])) break; if (_sp > XB_SPIN_CAP) { atomicAdd(&(bar)[XB_TMO], 1u); break; } } } } while (0)
struct XcdBarrier { unsigned* bar; unsigned x; volatile LAS unsigned* st; };
__device__ __forceinline__ XcdBarrier xcd_barrier_post(unsigned* bar, volatile LAS unsigned* st) {
    XcdBarrier b; b.bar = bar; b.x = xb_xcc_id(); b.st = st;
    if (threadIdx.x == 0) (void)xb_add(&bar[XB_XCNT(b.x)], 1u);
    return b;
}
__device__ __forceinline__ void xcd_barrier_complete(unsigned* bar, unsigned x, unsigned& nloc, unsigned& nx) {
    const unsigned Gd = gridDim.x * gridDim.y * gridDim.z;
    unsigned sum, cnt, mine, sp = 0u;
    for (;;) {
        sum = 0u; cnt = 0u; mine = 0u;
#pragma unroll
        for (unsigned j = 0; j < 16; ++j) { const unsigned c = xb_ld(&bar[XB_XCNT(j)]); sum += c; cnt += (c > 0u) ? 1u : 0u; mine = (j == x) ? c : mine; }
        if (sum == Gd) break;
        __builtin_amdgcn_s_sleep(1);
        if ((++sp & 255u) == 0u) { if (xb_ld(&bar[XB_TMO])) break; if (sp > XB_SPIN_CAP) { atomicAdd(&bar[XB_TMO], 1u); break; } }
    }
    nloc = mine > 0u ? mine : 1u; nx = cnt > 0u ? cnt : 1u;
}
__device__ __attribute__((noinline)) void xcd_barrier_fn(unsigned* bar, unsigned x, volatile LAS unsigned* st) {
    asm volatile("s_waitcnt vmcnt(0)" ::: "memory");
    __syncthreads();
    if (threadIdx.x == 0) {
        __builtin_amdgcn_s_waitcnt(0);
        unsigned nloc = st[0], nx = st[1]; const unsigned ep = st[2];
        if (nloc == 0u) { xcd_barrier_complete(bar, x, nloc, nx); st[0] = nloc; st[1] = nx; }
        st[2] = ep + 1u;
        const unsigned old = xb_add(&bar[XB_XSUB(x)], 1u);
        if (old + 1u == (ep + 1u) * nloc) {
            __builtin_amdgcn_fence(__ATOMIC_RELEASE, "agent");
            asm volatile("s_waitcnt vmcnt(0)" ::: "memory");
            const unsigned og = xb_add(&bar[XB_TOP], 1u);
            if (og + 1u == (ep + 1u) * nx) xb_add(&bar[XB_TOPGEN], 1u);
        }
        XB_SPIN(xb_ld(&bar[XB_TOPGEN]) <= ep, bar);
        __builtin_amdgcn_fence(__ATOMIC_ACQUIRE, "agent");
        asm volatile("s_waitcnt vmcnt(0)" ::: "memory");
    }
    __syncthreads();
}

#define XL_TAB   7000
#define XL_CNT(x) (7424 + 64 * (x))
__device__ __attribute__((noinline)) void xl_barrier_fn(unsigned* ctl, volatile LAS unsigned* st) {
    asm volatile("s_waitcnt vmcnt(0)" ::: "memory");
    __syncthreads();
    if (threadIdx.x == 0) {
        const unsigned ep = st[5]; st[5] = ep + 1u; const unsigned nl = gridDim.x / 8u; unsigned* cnt = ctl + XL_CNT(blockIdx.x & 7u);
        xb_add(cnt, 1u);
        XB_SPIN(xb_ld(cnt) < (ep + 1u) * nl, ctl);
        __builtin_amdgcn_fence(__ATOMIC_ACQUIRE, "agent");
        asm volatile("s_waitcnt vmcnt(0)" ::: "memory");
    }
    __syncthreads();
}
#define XP_CNT(p) (9000 + 16 * (p))
__device__ __attribute__((noinline)) void xp_barrier_fn(unsigned* ctl, int pm_arrive, int pm_wait, volatile LAS unsigned* st) {
    asm volatile("s_waitcnt vmcnt(0)" ::: "memory");
    __syncthreads();
    if (threadIdx.x == 0) {
        const unsigned ep = st[6]; st[6] = ep + 1u;
        xb_add(ctl + XP_CNT(pm_arrive), 1u);
        XB_SPIN(xb_ld(ctl + XP_CNT(pm_wait)) < (ep + 1u) * 4u, ctl);
        __builtin_amdgcn_fence(__ATOMIC_ACQUIRE, "agent");
        asm volatile("s_waitcnt vmcnt(0)" ::: "memory");
    }
    __syncthreads();
}
__device__ __forceinline__ void xl_census(unsigned* ctl, volatile LAS unsigned* st) {
    const int t = threadIdx.x; int ok = 1;
    if (t < (int)gridDim.x) ok = xb_ld(ctl + XL_TAB + t) == xb_ld(ctl + XL_TAB + (t & 7));
    if (t < 8 && t > 0) { for (int j = 0; j < t; ++j) ok = ok && (xb_ld(ctl + XL_TAB + t) != xb_ld(ctl + XL_TAB + j)); }
    const int all = __syncthreads_and(ok && (gridDim.x % 8u == 0u));
#if defined(XL_FORCE_OFF)
    if (t == 0) st[4] = 0u; (void)all;
#else
    if (t == 0) st[4] = all ? 1u : 0u;
#endif
    __syncthreads();
}

struct Frame {
    LAS unsigned char* lds; int tid, lane, wave, gw, NGW;
    float* out; unsigned char* ws;
};
__device__ __forceinline__ float wave_sum(float v, int lane) {
#pragma unroll
    for (int o = 1; o < 64; o <<= 1) v += pg8::shfl_xor_l(v, o, lane);
    return v;
}
constexpr int P0_PITCH = 144, P0_SCR = 64 * P0_PITCH;
struct P0Item { const float* W; const float* gain; bf16* WT; int N, ldt, k0; const unsigned* cmax; };
constexpr int P0_PER_LAYER = 6 * 704 + 2 * 256 + 64 + 16, P0_ITEMS = DEPTH * P0_PER_LAYER;
__device__ __forceinline__ P0Item p0_decode(const Args& A, unsigned char* ws, int it) {
    const int l = it / P0_PER_LAYER; int r = it % P0_PER_LAYER; bf16* wl = (bf16*)(ws + WS_W + (size_t)l * W_LAYER);
    const float* W; const float* g = nullptr; const float* ghi = nullptr; bf16* WT; int K, N, ldt, mode = 0, roff = 0, dk0 = 0, wmi = -1;
    if (r < 704) { W = A.in[6] + (size_t)l * D * FF; K = D; N = FF; g = A.in[5] + l * D; WT = wl + W_UP1 / 2; ldt = D; mode = 1; wmi = l * 2; }
    else if ((r -= 704) < 704) { W = A.in[7] + (size_t)l * D * FF; K = D; N = FF; g = A.in[5] + l * D; WT = wl + W_UP1 / 2; ldt = D; mode = 2; wmi = l * 2; }
    else if ((r -= 704) < 704) { W = A.in[8] + (size_t)l * FF * D; K = FF; N = D; WT = wl + W_DN1 / 2; ldt = FF; }
    else if ((r -= 704) < 704) { W = A.in[27] + (size_t)l * D * FF; K = D; N = FF; g = A.in[26] + l * D; WT = wl + W_UP2 / 2; ldt = D; mode = 1; wmi = l * 2 + 1; }
    else if ((r -= 704) < 704) { W = A.in[28] + (size_t)l * D * FF; K = D; N = FF; g = A.in[26] + l * D; WT = wl + W_UP2 / 2; ldt = D; mode = 2; wmi = l * 2 + 1; }
    else if ((r -= 704) < 704) { W = A.in[29] + (size_t)l * FF * D; K = FF; N = D; WT = wl + W_DN2 / 2; ldt = FF; }
    else if ((r -= 704) < 256) { W = A.in[10] + (size_t)l * D * D; K = D; N = D; g = A.in[9] + l * D; WT = wl + W_IN / 2; ldt = D; }
    else if ((r -= 256) < 256) { W = A.in[25] + (size_t)l * D * D; K = D; N = D; g = A.in[23] + l * SW; ghi = A.in[24] + l * PW; WT = wl + W_OUT / 2; ldt = D; }
    else if ((r -= 256) < 64) { W = A.in[19] + (size_t)l * SW * SW; K = SW; N = SW; WT = wl + W_GLU / 2; ldt = SW; }
    else { r -= 64; const int gi = r >> 2; r &= 3; W = A.in[21] + ((size_t)l * 4 + gi) * 128 * 128; K = 128; N = 128; WT = wl + W_POOL / 2; ldt = 256; roff = gi * 128; dk0 = (gi & 1) * 128; }
    (void)K; const int nblk = N / 64, kb = r / nblk, nb = r % nblk, k0 = 64 * kb, n0 = 64 * nb;
    const int dr = mode == 0 ? n0 : ((n0 >> 7) * 256 + (n0 & 127) + (mode == 2 ? 128 : 0));
    P0Item I; I.W = W + (size_t)k0 * N + n0; I.gain = g ? ((ghi && k0 >= 512) ? ghi + (k0 - 512) : g + k0) : nullptr; I.WT = WT + (size_t)(roff + dr) * ldt + dk0 + k0; I.N = N; I.ldt = ldt; I.k0 = k0; I.cmax = nullptr;
    if (I8U_ON && wmi >= 0) { I.WT = (bf16*)((unsigned char*)WT + (size_t)dr * D + k0); I.cmax = (const unsigned*)(ws + WS_CMAX) + wmi * 2 * FF + (mode == 2 ? FF : 0) + n0; }
    return I;
}
__device__ __forceinline__ void p0_load(const P0Item& I, f32x4 (&r0)[8], f32x4 (&r1)[8], int lane) {
    const int q = lane & 15, kp = lane >> 4;
#pragma unroll
    for (int s = 0; s < 8; ++s) { const float* wp = I.W + (size_t)(8 * s + 2 * kp) * I.N + 4 * q;
#if defined(P0_Q8_PLAIN)
        if (I.cmax != nullptr) { r0[s] = *(const f32x4*)wp; r1[s] = *(const f32x4*)(wp + I.N); } else
#endif
        { r0[s] = __builtin_nontemporal_load((const f32x4*)wp); r1[s] = __builtin_nontemporal_load((const f32x4*)(wp + I.N)); } }
}
__device__ __forceinline__ void p0_finish(const P0Item& I, const f32x4 (&r0)[8], const f32x4 (&r1)[8], LAS unsigned char* scr, int lane) {
    const int q = lane & 15, kp = lane >> 4;
    if (I8U_ON && I.cmax != nullptr) {
        const float M_ = 12582912.0f; float qj[4];
#pragma unroll
        for (int j = 0; j < 4; ++j) qj[j] = 127.0f / fmaxf(__uint_as_float(I.cmax[4 * q + j]), 1e-30f);
#pragma unroll
        for (int s = 0; s < 8; ++s) { const float g0 = I.gain[8 * s + 2 * kp], g1 = I.gain[8 * s + 2 * kp + 1];
#pragma unroll
            for (int j = 0; j < 4; ++j) { const unsigned b0 = __float_as_uint(__builtin_amdgcn_fmed3f(r0[s][j] * g0 * qj[j], -127.f, 127.f) + M_), b1 = __float_as_uint(__builtin_amdgcn_fmed3f(r1[s][j] * g1 * qj[j], -127.f, 127.f) + M_);
                *(LAS unsigned short*)(scr + (4 * q + j) * 80 + 8 * s + 2 * kp) = (unsigned short)((b0 & 0xffu) | ((b1 & 0xffu) << 8)); } }
        LDS_WAIT(); asm volatile("" ::: "memory");
#pragma unroll
        for (int i = 0; i < 4; ++i) { const int n = i * 16 + (lane >> 2), c = lane & 3; const v4u o = *(const LAS v4u*)(scr + n * 80 + c * 16);
            *(v4u*)((unsigned char*)I.WT + (size_t)n * D + 16 * c) = o; }
        LDS_WAIT(); asm volatile("" ::: "memory");
        return;
    }
#pragma unroll
    for (int s = 0; s < 8; ++s) { float g0 = 1.f, g1 = 1.f; if (I.gain) { g0 = I.gain[8 * s + 2 * kp]; g1 = I.gain[8 * s + 2 * kp + 1]; }
#pragma unroll
        for (int j = 0; j < 4; ++j) *(LAS unsigned*)(scr + (4 * q + j) * P0_PITCH + (4 * s + kp) * 4) = pg8::cvt_pk_bf16(r0[s][j] * g0, r1[s][j] * g1); }
    LDS_WAIT(); asm volatile("" ::: "memory");
    const int c = lane & 7;
#pragma unroll
    for (int i = 0; i < 8; ++i) { const int n = i * 8 + (lane >> 3); const v4u o = *(const LAS v4u*)(scr + n * P0_PITCH + c * 16);
        *(v4u*)(I.WT + (size_t)n * I.ldt + 8 * c) = o; }
    LDS_WAIT(); asm volatile("" ::: "memory");
}
__device__ __forceinline__ void init_row(const Frame& F, const float* src, bf16* xb, float* ssq, unsigned* xq, float* qs) {
    const f32x4* xr = (const f32x4*)src + F.lane; f32x4 v[4]; float s = 0.f; v2u w[4];
#pragma unroll
    for (int j = 0; j < 4; ++j) v[j] = __builtin_nontemporal_load(xr + 64 * j);
#pragma unroll
    for (int j = 0; j < 4; ++j) { w[j].x = pg8::cvt_pk_bf16(v[j].x, v[j].y); w[j].y = pg8::cvt_pk_bf16(v[j].z, v[j].w);
        const float a = pg8::bf_lo(w[j].x), b = pg8::bf_hi(w[j].x), c = pg8::bf_lo(w[j].y), d = pg8::bf_hi(w[j].y); s += (a * a + b * b) + (c * c + d * d); }
    s = wave_sum(s, F.lane);
#pragma unroll
    for (int j = 0; j < 4; ++j) ((v2u*)xb + F.lane)[64 * j] = w[j];
    if (F.lane < 32) ssq[F.lane] = F.lane == 0 ? s : 0.f;
    if (I8U_ON) { const float rv = __builtin_amdgcn_rsqf(s * (1.0f / D) + EPS), qi = rv * (127.0f / QCLIP0);
#pragma unroll
        for (int j = 0; j < 4; ++j) xq[F.lane + 64 * j] = pg8::q8_pack4(v[j].x * qi, v[j].y * qi, v[j].z * qi, v[j].w * qi);
        if (F.lane == 0) *qs = (QCLIP0 / 127.0f) * __builtin_amdgcn_rcpf(rv); }
}
struct S5Coef { float ar, ai, kr, ki; };
__device__ __forceinline__ S5Coef s5_coef(const Args& A, int l, int g, int p) {
    const float dt = expf(A.in[13][l * G + g]), lr = A.in[11][(l * G + g) * P + p], li = A.in[12][(l * G + g) * P + p];
    const float mag = expf(lr * dt); S5Coef c; c.ar = mag * cosf(li * dt); c.ai = mag * sinf(li * dt);
    const float den = lr * lr + li * li, nr = c.ar - 1.0f, ni = c.ai; c.kr = (nr * lr + ni * li) / den; c.ki = (ni * lr - nr * li) / den; return c;
}
typedef short bf16x8_t __attribute__((ext_vector_type(8)));
typedef float f32x16 __attribute__((ext_vector_type(16)));
constexpr int TR_PITCH = 272;
__device__ __forceinline__ float gelu_fast(float y) { const float z = 0.7978845608028654f * (y + 0.044715f * y * y * y); return y * __builtin_amdgcn_rcpf(1.0f + __builtin_amdgcn_exp2f(-2.0f * 1.4426950408889634f * z)); }

struct S5Tab { bf16x8_t tbb[4]; f32x2 a0, a1; bf16x8_t tc[4]; f32x4 dv; };
struct S5In { bf16x8_t af[2]; float hr0, hi0, hr1, hi1; v2u uw[2][2]; };
template <bool FINAL>
__device__ __forceinline__ void s5_load_tab(S5Tab& T, const Frame& F, const Args& A, const int l, const int g) {
    const unsigned char* tab = F.ws + WS_TAB; const int lane = F.lane, sg = lane & 31;
#pragma unroll
    for (int j = 0; j < 4; ++j) T.tbb[j] = ((const bf16x8_t*)(tab + TAB_BB))[((l * G + g) * 4 + j) * 64 + lane];
    T.a0 = ((const f32x2*)(tab + TAB_A))[(l * G + g) * P + sg]; T.a1 = ((const f32x2*)(tab + TAB_A))[(l * G + g) * P + sg + 32];
    if (FINAL) {
#pragma unroll
        for (int s = 0; s < 4; ++s) T.tc[s] = ((const bf16x8_t*)(tab + TAB_C))[((l * G + g) * 4 + s) * 64 + lane];
        T.dv = *(const f32x4*)(A.in[18] + (l * G + g) * H + 4 * (lane >> 4));
    }
}
template <bool FINAL>
__device__ __forceinline__ void s5_load_in(S5In& I, const Frame& F, const int row0, const int g) {
    const int lane = F.lane, sg = lane & 31, hf = lane >> 5, r = lane & 31;
    const bf16* up = (const bf16*)(F.ws + WS_U) + (size_t)(row0 + 32 * ((r >> 2) & 1) + (r & 3) + 4 * (r >> 3)) * D + g * H + 8 * hf;
    I.af[0] = *(const bf16x8_t*)up; I.af[1] = *(const bf16x8_t*)(up + (size_t)16 * D);
    I.hr0 = 0.f; I.hi0 = 0.f; I.hr1 = 0.f; I.hi1 = 0.f;
    if (FINAL) { const float* hinr = (const float*)(F.ws + WS_E + 2 * E_BYTES); const float* hini = (const float*)(F.ws + WS_E + 3 * E_BYTES);
        const size_t o = ((size_t)(row0 / 32 + hf) * G + g) * P + sg; I.hr0 = hinr[o]; I.hi0 = hini[o]; I.hr1 = hinr[o + 32]; I.hi1 = hini[o + 32];
        const int fr = lane & 15, fq = lane >> 4;
#pragma unroll
        for (int i = 0; i < 2; ++i)
#pragma unroll
            for (int rt = 0; rt < 2; ++rt) I.uw[i][rt] = *(const v2u*)((const bf16*)(F.ws + WS_U) + (size_t)(row0 + 32 * rt + 16 * i + fr) * D + g * H + 4 * fq); }
}
template <bool FINAL>
__device__ __forceinline__ void s5_unit(const Frame& F, const S5Tab& T, const S5In& I, const int row0, const int g, LAS unsigned char* tr) {
    const int lane = F.lane, sg = lane & 31, hf = lane >> 5;
    float hr0 = I.hr0, hi0 = I.hi0, hr1 = I.hr1, hi1 = I.hi1; const f32x2 a0 = T.a0, a1 = T.a1;
#pragma unroll
    for (int i = 0; i < 2; ++i) {
        const f32x16 z = {0.f, 0.f, 0.f, 0.f, 0.f, 0.f, 0.f, 0.f, 0.f, 0.f, 0.f, 0.f, 0.f, 0.f, 0.f, 0.f};
        const f32x16 x0 = __builtin_amdgcn_mfma_f32_32x32x16_bf16(I.af[i], T.tbb[0], z, 0, 0, 0);
        const f32x16 x1 = __builtin_amdgcn_mfma_f32_32x32x16_bf16(I.af[i], T.tbb[1], z, 0, 0, 0);
        const f32x16 x2 = __builtin_amdgcn_mfma_f32_32x32x16_bf16(I.af[i], T.tbb[2], z, 0, 0, 0);
        const f32x16 x3 = __builtin_amdgcn_mfma_f32_32x32x16_bf16(I.af[i], T.tbb[3], z, 0, 0, 0);
#pragma unroll
        for (int t = 0; t < 16; ++t) {
            const float n0r = __builtin_fmaf(-a0.y, hi0, __builtin_fmaf(a0.x, hr0, x0[t])), n0i = __builtin_fmaf(a0.y, hr0, __builtin_fmaf(a0.x, hi0, x2[t]));
            const float n1r = __builtin_fmaf(-a1.y, hi1, __builtin_fmaf(a1.x, hr1, x1[t])), n1i = __builtin_fmaf(a1.y, hr1, __builtin_fmaf(a1.x, hi1, x3[t]));
            hr0 = n0r; hi0 = n0i; hr1 = n1r; hi1 = n1i;
            if (FINAL) { v2u w; w.x = pg8::cvt_pk_bf16(hr0, hi0); w.y = pg8::cvt_pk_bf16(hr1, hi1); *(LAS v2u*)(tr + (hf * 16 + t) * TR_PITCH + 8 * sg) = w; }
        }
        if (FINAL) {
            const int fr = lane & 15, fq = lane >> 4;
#pragma unroll
            for (int rt = 0; rt < 2; ++rt) {
                f32x4 acc = {0.f, 0.f, 0.f, 0.f};
#pragma unroll
                for (int s = 0; s < 4; ++s) { const bf16x8_t hb = *(const LAS bf16x8_t*)(tr + (rt * 16 + fr) * TR_PITCH + s * 64 + fq * 16);
                    acc = __builtin_amdgcn_mfma_f32_16x16x32_bf16(T.tc[s], hb, acc, 0, 0, 0); }
                const int trow = row0 + 32 * rt + 16 * i + fr;
                const v2u uw = I.uw[i][rt];
                const float uv[4] = {pg8::bf_lo(uw.x), pg8::bf_hi(uw.x), pg8::bf_lo(uw.y), pg8::bf_hi(uw.y)};
                float y[4];
#pragma unroll
                for (int e = 0; e < 4; ++e) y[e] = gelu_fast(acc[e] + T.dv[e] * uv[e]);
                v2u w; w.x = pg8::cvt_pk_bf16(y[0], y[1]); w.y = pg8::cvt_pk_bf16(y[2], y[3]);
                *(v2u*)((bf16*)(F.ws + WS_GB) + (size_t)trow * SW + g * H + 4 * fq) = w;
            }
            asm volatile("s_waitcnt lgkmcnt(0)" ::: "memory");
        }
    }
    if (!FINAL) {
        float* er = (float*)(F.ws + WS_E); float* ei = (float*)(F.ws + WS_E + E_BYTES);
        const size_t o = ((size_t)(row0 / 32 + hf) * G + g) * P + sg; er[o] = hr0; ei[o] = hi0; er[o + 32] = hr1; ei[o + 32] = hi1;
    }
}
__device__ __forceinline__ int s5_chunk_of(int lu, int x) { const int cl = lu / G; return cl < 32 ? 32 * x + cl : MP / 64 + 2 * x + (cl - 32); }
template <bool FINAL>
__device__ __forceinline__ void s5_units(const Frame& F, const Args& A, const int l, LAS unsigned char* tr) {
    constexpr int NUL = 34 * G;
    const int x = blockIdx.x & 7, lw = (blockIdx.x >> 3) * 8 + F.wave, nlw = (gridDim.x >> 3) * 8;
#if defined(SCAN_BALANCE)
    const bool bal = nlw == 256;
#define S5_UNIT_AT(r) (bal ? ((r) < 4 ? lw + (r) * 256 : (((r) == 4 && F.wave < 2) ? 1024 + (int)(blockIdx.x >> 3) * 2 + F.wave : NUL)) : lw + (r) * nlw)
#else
#define S5_UNIT_AT(r) (lw + (r) * nlw)
#endif
    int r = 0, it = S5_UNIT_AT(0); if (it >= NUL) return;
    S5Tab T; int gl = it % G; s5_load_tab<FINAL>(T, F, A, l, gl);
    S5In cur; s5_load_in<FINAL>(cur, F, s5_chunk_of(it, x) * 64, gl);
    for (;;) {
        const int nx = S5_UNIT_AT(r + 1); S5In nxt = cur; const int gn = nx % G;
        if (nx < NUL) s5_load_in<FINAL>(nxt, F, s5_chunk_of(nx, x) * 64, gn);
        s5_unit<FINAL>(F, T, cur, s5_chunk_of(it, x) * 64, gl, tr);
        if (nx >= NUL) break;
        if (gn != gl) { s5_load_tab<FINAL>(T, F, A, l, gn); gl = gn; }
        cur = nxt; it = nx; ++r;
    }
#undef S5_UNIT_AT
}

template <int W>
__device__ __forceinline__ void pool_unit(const Frame& F, const float* hist, const int sc, const int grp) {
    const int rowb = sc * 32, c = grp * 128 + 2 * F.lane; const bool prompt = rowb < MP;
    const int t0 = prompt ? (rowb & (PL - 1)) : ((rowb - MP) & (SL - 1)), strm = prompt ? 0 : (rowb - MP) / SL;
    const bf16* ucol = (const bf16*)(F.ws + WS_U) + (size_t)rowb * D + SW + c; bf16* pcol = (bf16*)(F.ws + WS_PRE) + (size_t)rowb * PW + c;
    f32x2 v[31 + W];
    if (t0 == 0) {
#pragma unroll
        for (int dt = -(W - 1); dt < 0; ++dt) v[dt + W - 1] = prompt ? (f32x2){0.f, 0.f} : *(const f32x2*)(hist + ((size_t)strm * HIST + (HIST + dt)) * PW + c);
    } else {
#pragma unroll
        for (int dt = -(W - 1); dt < 0; ++dt) { const unsigned w = *(const unsigned*)(ucol + (ptrdiff_t)dt * D); v[dt + W - 1] = (f32x2){pg8::bf_lo(w), pg8::bf_hi(w)}; }
    }
#pragma unroll
    for (int dt = 0; dt < 32; ++dt) { const unsigned w = *(const unsigned*)(ucol + (size_t)dt * D); v[dt + W - 1] = (f32x2){pg8::bf_lo(w), pg8::bf_hi(w)}; }
    f32x2 s = {0.f, 0.f};
#pragma unroll
    for (int j = 0; j < W - 1; ++j) s += v[j];
    const bool head = prompt && t0 == 0;
#pragma unroll
    for (int dt = 0; dt < 32; ++dt) {
        s += v[dt + W - 1];
        const float inv = head ? 1.0f / (float)(dt + 1 < W ? dt + 1 : W) : 1.0f / (float)W;
        const f32x2 pre = s * inv - v[dt + W - 1];
        *(unsigned*)(pcol + (size_t)dt * PW) = pg8::cvt_pk_bf16(pre.x, pre.y);
        s -= v[dt];
    }
}

template <int PART>
__device__ __forceinline__ void phase_m1(const Frame& F, const Args& A, const int l) {
    if (PART & 1) s5_units<false>(F, A, l, nullptr);
    if (!(PART & 2)) return;
    const float* hist = A.in[4] + (size_t)l * SB * HIST * PW;
#if defined(M2_BALANCE)
    { const int b = blockIdx.x, nh = gridDim.x / 2, nw2 = nh * 8, total = NSC * 4;
      for (int r = 0; r < 3; ++r) { int it = -1;
          if (b >= nh) { if (r < 2) it = r * nw2 + (b - nh) * 8 + F.wave; }
          else if (F.wave == 0) it = 2 * nw2 + b + r * nh;
          if (it < 0 || it >= total) continue;
          const int sc = it >> 2, grp = it & 3;
          if (grp == 0) pool_unit<2>(F, hist, sc, 0); else if (grp == 1) pool_unit<4>(F, hist, sc, 1); else if (grp == 2) pool_unit<8>(F, hist, sc, 2); else pool_unit<16>(F, hist, sc, 3); } }
#else
    for (int it = F.gw; it < NSC * 4; it += F.NGW) {
        const int sc = it >> 2, grp = it & 3;
        if (grp == 0) pool_unit<2>(F, hist, sc, 0); else if (grp == 1) pool_unit<4>(F, hist, sc, 1); else if (grp == 2) pool_unit<8>(F, hist, sc, 2); else pool_unit<16>(F, hist, sc, 3);
    }
#endif
    float* tail_p = F.out + (size_t)M * D + 2 * DEPTH * PB * G * P + (size_t)l * PB * HIST * PW;
    float* tail_s = F.out + (size_t)M * D + 2 * DEPTH * PB * G * P + DEPTH * PB * HIST * PW + 2 * DEPTH * SB * G * P + (size_t)l * SB * HIST * PW;
    for (int it = F.gw; it < (PB + SB) * HIST; it += F.NGW) {
        const int strm = it / HIST, k = it % HIST; const bool prompt = strm < PB;
        const int row = prompt ? strm * PL + PL - HIST + k : MP + (strm - PB) * SL + SL - HIST + k;
        const v4u w = *((const v4u*)((const bf16*)(F.ws + WS_U) + (size_t)row * D + SW) + F.lane);
        f32x4* dst = (f32x4*)((prompt ? tail_p + (size_t)strm * HIST * PW : tail_s + (size_t)(strm - PB) * HIST * PW) + (size_t)k * PW) + 2 * F.lane;
        dst[0] = (f32x4){pg8::bf_lo(w.x), pg8::bf_hi(w.x), pg8::bf_lo(w.y), pg8::bf_hi(w.y)}; dst[1] = (f32x4){pg8::bf_lo(w.z), pg8::bf_hi(w.z), pg8::bf_lo(w.w), pg8::bf_hi(w.w)};
    }
}

__device__ __forceinline__ void phase_m2(const Frame& F, const Args& A, const int l, const int bid) {
    phase_m1<2>(F, A, l);
    const float* er = (const float*)(F.ws + WS_E); const float* ei = (const float*)(F.ws + WS_E + E_BYTES);
    float* hinr = (float*)(F.ws + WS_E + 2 * E_BYTES); float* hini = (float*)(F.ws + WS_E + 3 * E_BYTES);
    const unsigned char* tab = F.ws + WS_TAB;
    float* o_re_p = F.out + (size_t)M * D, *o_im_p = o_re_p + DEPTH * PB * G * P;
    float* o_re_s = o_im_p + DEPTH * PB * G * P + DEPTH * PB * HIST * PW, *o_im_s = o_re_s + DEPTH * SB * G * P;
    if (bid < 128) {
        const int b = bid >> 6, gp = (bid & 63) * 32 + (F.tid & 31), seg = F.tid >> 5;
        const f32x2 a32 = ((const f32x2*)(tab + TAB_A32))[l * G * P + gp];
        const size_t base = ((size_t)b * 256 + seg * 16) * (G * P) + gp;
        float e_r[16], e_i[16];
#pragma unroll
        for (int c = 0; c < 16; ++c) { e_r[c] = er[base + (size_t)c * (G * P)]; e_i[c] = ei[base + (size_t)c * (G * P)]; }
        float hr = 0.f, hi = 0.f;
#pragma unroll
        for (int c = 0; c < 16; ++c) { const float nr = a32.x * hr - a32.y * hi + e_r[c], ni = a32.x * hi + a32.y * hr + e_i[c]; hr = nr; hi = ni; }
        LAS f32x2* sf = (LAS f32x2*)F.lds;
        sf[seg * 32 + (F.tid & 31)] = (f32x2){hr, hi};
        float pr = a32.x, pi = a32.y;
#pragma unroll
        for (int s = 0; s < 4; ++s) { const float nr = pr * pr - pi * pi, ni = 2.0f * pr * pi; pr = nr; pi = ni; }
        __syncthreads();
        hr = 0.f; hi = 0.f;
        for (int s = 0; s < seg; ++s) { const f32x2 f = sf[s * 32 + (F.tid & 31)]; const float nr = pr * hr - pi * hi + f.x, ni = pr * hi + pi * hr + f.y; hr = nr; hi = ni; }
#pragma unroll
        for (int c = 0; c < 16; ++c) { hinr[base + (size_t)c * (G * P)] = hr; hini[base + (size_t)c * (G * P)] = hi;
            const float nr = a32.x * hr - a32.y * hi + e_r[c], ni = a32.x * hi + a32.y * hr + e_i[c]; hr = nr; hi = ni; }
        if (seg == 15) { o_re_p[((size_t)l * PB + b) * (G * P) + gp] = hr; o_im_p[((size_t)l * PB + b) * (G * P) + gp] = hi; }
        __syncthreads();
    } else {
        for (int i = (bid - 128) * 512 + F.tid; i < SB * G * P; i += 128 * 512) {
            const int s = i / (G * P), gp = i % (G * P);
            const f32x2 a32 = ((const f32x2*)(tab + TAB_A32))[l * G * P + gp];
            float hr = A.in[2][((size_t)l * SB + s) * (G * P) + gp], hi = A.in[3][((size_t)l * SB + s) * (G * P) + gp];
            const size_t base = ((size_t)(MP / 32) + 2 * s) * (G * P) + gp;
#pragma unroll
            for (int c = 0; c < 2; ++c) { hinr[base + (size_t)c * (G * P)] = hr; hini[base + (size_t)c * (G * P)] = hi;
                const float e0 = er[base + (size_t)c * (G * P)], e1 = ei[base + (size_t)c * (G * P)];
                const float nr = a32.x * hr - a32.y * hi + e0, ni = a32.x * hi + a32.y * hr + e1; hr = nr; hi = ni; }
            o_re_s[((size_t)l * SB + s) * (G * P) + gp] = hr; o_im_s[((size_t)l * SB + s) * (G * P) + gp] = hi;
        }
    }
}

__device__ __forceinline__ void phase_m3(const Frame& F, const Args& A, const int l) {
    s5_units<true>(F, A, l, F.lds + F.wave * (32 * TR_PITCH));
}

#define MIXER_M1(L) phase_m1<1>(F, a, L);
#define MIXER_M2(L) phase_m2(F, a, L, bid);
#define MIXER_M3(L) phase_m3(F, a, L);
#if defined(DEFER_L1)
constexpr int P0_DEFER = DEFER_L1;
constexpr int P0_EARLY_ITEMS = P0_ITEMS - 2 * P0_DEFER;
#else
constexpr int P0_EARLY_ITEMS = P0_ITEMS;
#endif
__device__ __forceinline__ int p0_order(int pos) {
#if defined(I8U) && defined(P0_Q8_FIRST)
    static_assert(P0_ITEMS - P0_EARLY_ITEMS <= P0_PER_LAYER - 3520, "the deferred tail must lie inside the last layer's non-int8 tail");
    constexpr int NQ = 4 * 704, NQ_ALL = DEPTH * NQ;
    if (pos >= P0_EARLY_ITEMS) return pos;
    if (pos < NQ_ALL) { const int l = pos / NQ, rr = pos % NQ; return l * P0_PER_LAYER + (rr < 1408 ? rr : rr + 704); }
    int q = pos - NQ_ALL;
    constexpr int NO = P0_PER_LAYER - NQ; const int l = q / NO; q %= NO;
    return l * P0_PER_LAYER + (q < 704 ? 1408 + q : 3520 + (q - 704));
#elif defined(I8U) && defined(P0_FUSE)
    static_assert(P0_ITEMS - P0_EARLY_ITEMS <= P0_PER_LAYER - 3520, "the deferred tail must lie inside the last layer's non-int8 tail");
    if (pos >= P0_EARLY_ITEMS) return pos;
    constexpr int NO = P0_PER_LAYER - 4 * 704; const int l = pos / NO, q = pos % NO;
    return l * P0_PER_LAYER + (q < 704 ? 1408 + q : 3520 + (q - 704));
#else
    return pos;
#endif
}
__device__ __forceinline__ void p0_convert(const Frame& F, const Args& A, LAS unsigned char* scr, const int lo, const int hi, const int w, const int nw) {
    int it = lo + w;
    if (it < hi) {
        P0Item cur = p0_decode(A, F.ws, p0_order(it)); f32x4 r0[8], r1[8]; p0_load(cur, r0, r1, F.lane);
        for (;;) {
            const int nx = it + nw; const bool more = nx < hi; P0Item nxt = cur; f32x4 n0[8], n1[8];
            if (more) { nxt = p0_decode(A, F.ws, p0_order(nx)); p0_load(nxt, n0, n1, F.lane); }
            p0_finish(cur, r0, r1, scr, F.lane);
            if (!more) break;
#pragma unroll
            for (int s = 0; s < 8; ++s) { r0[s] = n0[s]; r1[s] = n1[s]; }
            cur = nxt; it = nx;
        }
    }
}
__device__ __forceinline__ void p0_xinit_tables(const Frame& F, const Args& A) {
#define in A.in
    for (int m = F.gw; m < M; m += F.NGW) {
        const float* src = m < MP ? in[0] + (size_t)m * D : in[1] + (size_t)(m - MP) * D;
        init_row(F, src, (bf16*)(F.ws + WS_XB) + (size_t)m * D, (float*)(F.ws + WS_SSQ) + (size_t)m * 32, (unsigned*)(F.ws + WS_XQ + (size_t)m * D), (float*)(F.ws + WS_QSB) + m);
    }
    unsigned char* tab = F.ws + WS_TAB;
    for (int i = F.gw * 64 + F.lane; i < DEPTH * G * P; i += F.NGW * 64) {
        const int p = i % P, g = (i / P) % G, l = i / (P * G); const S5Coef c = s5_coef(A, l, g, p);
        ((f32x2*)(tab + TAB_A))[i] = (f32x2){c.ar, c.ai};
        float r = c.ar, im = c.ai;
#pragma unroll
        for (int s = 0; s < 5; ++s) { const float nr = r * r - im * im, ni = 2.0f * r * im; r = nr; im = ni; }
        ((f32x2*)(tab + TAB_A32))[i] = (f32x2){r, im};
    }
    for (int i = F.gw * 64 + F.lane; i < DEPTH * G * 4 * 64; i += F.NGW * 64) {
        const int ln = i & 63, j = (i >> 6) & 3, g = (i >> 8) % G, l = i / (256 * G);
        {
            const int c = ln & 31, hf = ln >> 5, p = 32 * (j & 1) + c; const S5Coef cf = s5_coef(A, l, g, p); float v[8];
#pragma unroll
            for (int e = 0; e < 8; ++e) { const int ch = 8 * hf + e; const float br = in[14][((size_t)(l * G + g) * P + p) * H + ch], bi = in[15][((size_t)(l * G + g) * P + p) * H + ch];
                v[e] = j < 2 ? cf.kr * br - cf.ki * bi : cf.kr * bi + cf.ki * br; }
            ((v4u*)(tab + TAB_BB))[i] = (v4u){pk2(v[0], v[1]), pk2(v[2], v[3]), pk2(v[4], v[5]), pk2(v[6], v[7])};
        }
        {
            const int ch = ln & 15, fq = ln >> 4; float v[8];
#pragma unroll
            for (int e = 0; e < 8; ++e) { const int k = 32 * j + 8 * fq + e, sg = k >> 2, comp = k & 3, p = sg + 32 * (comp >> 1);
                v[e] = (comp & 1) ? -in[17][((size_t)(l * G + g) * H + ch) * P + p] : in[16][((size_t)(l * G + g) * H + ch) * P + p]; }
            ((v4u*)(tab + TAB_C))[i] = (v4u){pk2(v[0], v[1]), pk2(v[2], v[3]), pk2(v[4], v[5]), pk2(v[6], v[7])};
        }
    }
#undef in
}
__device__ __forceinline__ void phase_wmax(const Frame& F, const Args& A) {
    LAS float* red = (LAS float*)F.lds; const int nblk = F.NGW / 8, blk = F.gw / 8;
    constexpr int NCB = FF / 256, NT = 2 * DEPTH * 2 * NCB * 8;
#if defined(WMAX_PIPE)
    for (int t0 = blk; t0 < NT; t0 += 3 * nblk) {
        f32x4 v[3][16]; f32x4 m[3];
#pragma unroll
        for (int j = 0; j < 3; ++j) { const int t = t0 + j * nblk; if (t < NT) {
            const int kc = t & 7, cb = (t >> 3) % NCB, mi = (t >> 3) / NCB, gu = mi & 1, f = (mi >> 1) & 1, l = (DEPTH - 1) - (mi >> 2);
            const float* W = A.in[f == 0 ? (gu == 0 ? 6 : 7) : (gu == 0 ? 27 : 28)] + ((size_t)l * D + kc * 128 + F.wave * 16) * FF + cb * 256 + 4 * F.lane;
#pragma unroll
            for (int i = 0; i < 16; ++i) v[j][i] = __builtin_nontemporal_load((const f32x4*)(W + (size_t)i * FF)); } }
#pragma unroll
        for (int j = 0; j < 3; ++j) { const int t = t0 + j * nblk; m[j] = (f32x4){0.f, 0.f, 0.f, 0.f}; if (t < NT) {
            const int kc = t & 7, mi = (t >> 3) / NCB, f = (mi >> 1) & 1, l = (DEPTH - 1) - (mi >> 2);
            const float* gp = A.in[f == 0 ? 5 : 26] + l * D + kc * 128 + F.wave * 16;
#pragma unroll
            for (int i = 0; i < 16; ++i) { const float g = fabsf(gp[i]); m[j].x = fmaxf(m[j].x, fabsf(v[j][i].x) * g); m[j].y = fmaxf(m[j].y, fabsf(v[j][i].y) * g); m[j].z = fmaxf(m[j].z, fabsf(v[j][i].z) * g); m[j].w = fmaxf(m[j].w, fabsf(v[j][i].w) * g); } }
            *(LAS f32x4*)(red + (j * 8 + F.wave) * 256 + 4 * F.lane) = m[j]; }
        __syncthreads();
#pragma unroll
        for (int j = 0; j < 3; ++j) { const int t = t0 + j * nblk; if (t < NT && F.tid < 256) {
            const int cb = (t >> 3) % NCB, mi = (t >> 3) / NCB, gu = mi & 1, f = (mi >> 1) & 1, l = (DEPTH - 1) - (mi >> 2); float mx = 0.f;
#pragma unroll
            for (int w = 0; w < 8; ++w) mx = fmaxf(mx, red[(j * 8 + w) * 256 + F.tid]);
            __hip_atomic_fetch_max((unsigned*)(F.ws + WS_CMAX) + (l * 2 + f) * 2 * FF + gu * FF + cb * 256 + F.tid, __float_as_uint(mx), __ATOMIC_RELAXED, __HIP_MEMORY_SCOPE_AGENT); } }
        __syncthreads();
    }
#else
    for (int t = blk; t < NT; t += nblk) {
        const int kc = t & 7, cb = (t >> 3) % NCB, mi = (t >> 3) / NCB, gu = mi & 1, f = (mi >> 1) & 1, l = (DEPTH - 1) - (mi >> 2);
        const float* W = A.in[f == 0 ? (gu == 0 ? 6 : 7) : (gu == 0 ? 27 : 28)] + ((size_t)l * D + kc * 128 + F.wave * 16) * FF + cb * 256 + 4 * F.lane;
        const float* gp = A.in[f == 0 ? 5 : 26] + l * D + kc * 128 + F.wave * 16;
        f32x4 v[16];
#pragma unroll
#if defined(WMAX_NT)
        for (int i = 0; i < 16; ++i) v[i] = __builtin_nontemporal_load((const f32x4*)(W + (size_t)i * FF));
#else
        for (int i = 0; i < 16; ++i) v[i] = *(const f32x4*)(W + (size_t)i * FF);
#endif
        f32x4 m = {0.f, 0.f, 0.f, 0.f};
#pragma unroll
        for (int i = 0; i < 16; ++i) { const float g = fabsf(gp[i]); m.x = fmaxf(m.x, fabsf(v[i].x) * g); m.y = fmaxf(m.y, fabsf(v[i].y) * g); m.z = fmaxf(m.z, fabsf(v[i].z) * g); m.w = fmaxf(m.w, fabsf(v[i].w) * g); }
        *(LAS f32x4*)(red + F.wave * 256 + 4 * F.lane) = m;
        __syncthreads();
        if (F.tid < 256) { float mx = 0.f;
#pragma unroll
            for (int w = 0; w < 8; ++w) mx = fmaxf(mx, red[w * 256 + F.tid]);
            __hip_atomic_fetch_max((unsigned*)(F.ws + WS_CMAX) + (l * 2 + f) * 2 * FF + gu * FF + cb * 256 + F.tid, __float_as_uint(mx), __ATOMIC_RELAXED, __HIP_MEMORY_SCOPE_AGENT); }
        __syncthreads();
    }
#endif
}
#if defined(I8U) && defined(P0_FUSE)
constexpr int Q8_CMAX_OFF = 64 * 2048, Q8_TASKS = 2 * DEPTH * 2 * (FF / 64);
__device__ __forceinline__ void p0_q8_tasks(const Frame& F, const Args& A) {
    LAS unsigned char* img = F.lds; LAS unsigned* cml = (LAS unsigned*)(F.lds + Q8_CMAX_OFF);
    const int nblk = F.NGW / 8, blk = F.gw / 8, q = F.lane & 15, kp = F.lane >> 4;
    for (int t = blk; t < Q8_TASKS; t += nblk) {
        const int mi = t / (FF / 64), cb = t % (FF / 64), gu = mi & 1, f = (mi >> 1) & 1, l = mi >> 2, n0 = cb * 64;
        const float* Wm = A.in[f == 0 ? (gu == 0 ? 6 : 7) : (gu == 0 ? 27 : 28)] + (size_t)l * D * FF + n0 + 4 * q;
        const float* gn = A.in[f == 0 ? 5 : 26] + l * D;
        if (F.tid < 64) cml[F.tid] = 0u;
        __syncthreads();
        float mx[4] = {0.f, 0.f, 0.f, 0.f};
#pragma unroll 1
        for (int rr = 0; rr < 2; ++rr) {
            const int kb = (rr * 8 + F.wave) * 64; f32x4 r0[8], r1[8];
#pragma unroll
            for (int s = 0; s < 8; ++s) { const float* wp = Wm + (size_t)(kb + 8 * s + 2 * kp) * FF; r0[s] = __builtin_nontemporal_load((const f32x4*)wp); r1[s] = __builtin_nontemporal_load((const f32x4*)(wp + FF)); }
#pragma unroll
            for (int s = 0; s < 8; ++s) { const int k = kb + 8 * s + 2 * kp; const float g0 = gn[k], g1 = gn[k + 1];
                const int dw = (k >> 1), ch = dw >> 2;
#pragma unroll
                for (int j = 0; j < 4; ++j) { const float a = r0[s][j] * g0, b = r1[s][j] * g1; mx[j] = fmaxf(mx[j], fmaxf(fabsf(a), fabsf(b)));
                    *(LAS unsigned*)(img + (4 * q + j) * 2048 + (((ch ^ (q & 7)) << 2) | (dw & 3)) * 4) = pg8::cvt_pk_bf16(a, b); } }
        }
#pragma unroll
        for (int j = 0; j < 4; ++j) { mx[j] = fmaxf(mx[j], pg8::shfl_xor_l(mx[j], 16, F.lane)); mx[j] = fmaxf(mx[j], pg8::shfl_xor_l(mx[j], 32, F.lane)); }
        if (kp == 0) {
#pragma unroll
            for (int j = 0; j < 4; ++j) __hip_atomic_fetch_max(cml + 4 * q + j, __float_as_uint(mx[j]), __ATOMIC_RELAXED, __HIP_MEMORY_SCOPE_WORKGROUP); }
        __syncthreads();
        if (F.tid < 64) ((unsigned*)(F.ws + WS_CMAX))[(l * 2 + f) * 2 * FF + gu * FF + n0 + F.tid] = cml[F.tid];
        unsigned char* wq = F.ws + WS_W + (size_t)l * W_LAYER + (f == 0 ? W_UP1 : W_UP2);
#pragma unroll
        for (int i = 0; i < 8; ++i) { const int pp = F.tid + 512 * i, n = pp >> 6, c = pp & 63, sw = (n >> 2) & 7;
            const float qi = 127.0f / fmaxf(__uint_as_float(cml[n]), 1e-30f);
            const v4u a = *(const LAS v4u*)(img + n * 2048 + (((2 * c) ^ sw) << 4)), b = *(const LAS v4u*)(img + n * 2048 + (((2 * c + 1) ^ sw) << 4));
            v4u o;
            o.x = pg8::q8_pack4(pg8::bf_lo(a.x) * qi, pg8::bf_hi(a.x) * qi, pg8::bf_lo(a.y) * qi, pg8::bf_hi(a.y) * qi); o.y = pg8::q8_pack4(pg8::bf_lo(a.z) * qi, pg8::bf_hi(a.z) * qi, pg8::bf_lo(a.w) * qi, pg8::bf_hi(a.w) * qi);
            o.z = pg8::q8_pack4(pg8::bf_lo(b.x) * qi, pg8::bf_hi(b.x) * qi, pg8::bf_lo(b.y) * qi, pg8::bf_hi(b.y) * qi); o.w = pg8::q8_pack4(pg8::bf_lo(b.z) * qi, pg8::bf_hi(b.z) * qi, pg8::bf_lo(b.w) * qi, pg8::bf_hi(b.w) * qi);
            const int dr = ((n0 + n) >> 7) * 256 + ((n0 + n) & 127) + (gu ? 128 : 0);
            *(v4u*)(wq + (size_t)dr * D + 16 * c) = o; }
        __syncthreads();
    }
}
#endif
#ifndef P0_W2
#define P0_W2 5
#endif
#if defined(I8U) && defined(P0_FUSE)
__device__ __forceinline__ void phase_p0_rest(const Frame& F, const Args& A, LAS unsigned char* scr);
#endif
__device__ __forceinline__ void phase_p0(const Frame& F, const Args& A) {
    LAS unsigned char* scr = F.lds + F.wave * P0_SCR;
#define in A.in
#if defined(I8U) && defined(P0_FUSE)
    p0_q8_tasks(F, A);
    { const int nblk = F.NGW / 8, blk = F.gw / 8, n2 = Q8_TASKS > nblk ? Q8_TASKS - nblk : 0;
      constexpr int W2 = P0_W2;
      const bool two = blk < n2; if (two && F.wave >= W2) return;
      const int lane2 = pg8::fresh_lane(); Frame G_ = F; G_.lane = lane2; G_.tid = F.wave * 64 + lane2;
      G_.gw = two ? blk * W2 + F.wave : n2 * W2 + (blk - n2) * 8 + F.wave; G_.NGW = n2 * W2 + (nblk - n2) * 8;
      phase_p0_rest(G_, A, scr); }
    return;
}
__device__ __forceinline__ void phase_p0_rest(const Frame& F, const Args& A, LAS unsigned char* scr) {
    p0_convert(F, A, scr, 0, P0_EARLY_ITEMS - DEPTH * 4 * 704, F.gw, F.NGW);
#else
    p0_convert(F, A, scr, 0, P0_EARLY_ITEMS, F.gw, F.NGW);
#endif
    for (int l = 0; l < DEPTH; ++l) {
        bf16* wl = (bf16*)(F.ws + WS_W + (size_t)l * W_LAYER);
        for (int i = F.gw * 64 + F.lane; i < 512 * 16; i += F.NGW * 64) { const int n = i >> 4, c = i & 15, gi = n >> 7;
            *(v4u*)(wl + W_POOL / 2 + (size_t)n * 256 + ((gi & 1) ^ 1) * 128 + c * 8) = (v4u){0u, 0u, 0u, 0u}; }
    }
#if !defined(I8U) || !defined(P0_XINIT_EARLY)
    p0_xinit_tables(F, A);
#endif
}
#undef in
__device__ __forceinline__ void phase_fin(const Frame& F, const Args& A) {
    const float* gn = A.in[30];
    for (int m = F.gw; m < M; m += F.NGW) {
        const float* sp = (const float*)(F.ws + WS_SSQ) + (size_t)m * 32; float s = F.lane < 32 ? sp[F.lane] : 0.f; s = wave_sum(s, F.lane);
        const float r = __builtin_amdgcn_rsqf(s * (1.0f / D) + EPS);
        const v2u* xr = (const v2u*)((const bf16*)(F.ws + WS_XB) + (size_t)m * D) + F.lane; f32x4* yr = (f32x4*)(F.out + (size_t)m * D) + F.lane; const f32x4* gr = (const f32x4*)gn + F.lane;
#pragma unroll
#if defined(FIN_NT)
        for (int j = 0; j < 4; ++j) { const v2u w = __builtin_nontemporal_load(xr + 64 * j); const f32x4 gg = gr[64 * j];
#else
        for (int j = 0; j < 4; ++j) { const v2u w = xr[64 * j]; const f32x4 gg = gr[64 * j];
#endif
            __builtin_nontemporal_store((f32x4){pg8::bf_lo(w.x) * r * gg.x, pg8::bf_hi(w.x) * r * gg.y, pg8::bf_lo(w.y) * r * gg.z, pg8::bf_hi(w.y) * r * gg.w}, yr + 64 * j); }
    }
}
#define PH_SETUP \
    const int tid_ = wid0 * 64 + pg8::fresh_lane(); const Args& a = kargs(); unsigned char* ws_ = a.ws; \
    Frame F; F.lds = (LAS unsigned char*)lds_raw; F.tid = tid_; F.lane = F.tid & 63; F.wave = wid0; \
    const int Gd = gridDim.x, bid = blockIdx.x; \
    { const int vcu = (Gd % 8 == 0) ? (bid % 8) * (Gd / 8) + bid / 8 : bid; F.gw = vcu * 8 + F.wave; F.NGW = Gd * 8; } \
    F.out = a.out; F.ws = ws_; (void)Gd; (void)bid;

template <int L, int K, bool DRY>
__device__ __forceinline__ void run_phase(unsigned char* lds_raw, const int wid0) {
    PH_SETUP
    constexpr size_t WL = WS_W + (size_t)(L < 0 ? 0 : L) * W_LAYER;
    if constexpr (K == 100) phase_p0(F, a);
    else if constexpr (K == 102) { phase_wmax(F, a);
#if defined(P0_XINIT_EARLY)
        p0_xinit_tables(F, a);
#endif
    }
    else if constexpr (K == 101) phase_fin(F, a);
    else if constexpr (K == 0 || K == 8) {
        constexpr int KE = I8U_ON ? D / 2 : D;
        pg8::Gemm g{(bf16*)(ws_ + (I8U_ON ? WS_XQ : WS_XB)), (bf16*)(ws_ + WL + (K == 0 ? W_UP1 : W_UP2)), KE, KE, KE, 0, 0}; pg8::StaticOrder S; S.init(M, 2 * FF, KE, Gd, bid);
        if constexpr (K == 0) { pg8::EpiUp<0> E{L}; pg8::gemm_phase<false>(F.lds, F.tid, F.wave, g, S, E); } else { pg8::EpiUp<1> E{L}; pg8::gemm_phase<false>(F.lds, F.tid, F.wave, g, S, E); }
#if defined(DEFER_L1)
        if constexpr (L == 0 && !DRY) {
            constexpr int NT = (M / 256) * (2 * FF / 256); const int nlast = NT - (NT / Gd) * Gd, nidle = Gd - nlast;
            if (nlast > 0 && bid >= nlast) { const int lo = P0_EARLY_ITEMS + (K == 0 ? 0 : P0_DEFER), hi = lo + P0_DEFER;
                const int lane2 = pg8::fresh_lane(); Frame F2 = F; F2.lane = lane2; F2.tid = wid0 * 64 + lane2;
                p0_convert(F2, a, F.lds + F.wave * P0_SCR, lo, hi, (bid - nlast) * 8 + F.wave, nidle * 8); }
        }
#endif
    } else if constexpr (K == 1 || K == 9) {
        pg8::Gemm g{(bf16*)(ws_ + WS_H), (bf16*)(ws_ + WL + (K == 1 ? W_DN1 : W_DN2)), FF, FF, FF, 0, MP}; pg8::StaticOrder S; S.init(MP, D, FF, Gd, bid);
#if defined(RES_WT)
        constexpr bool WTD = true;
#else
        constexpr bool WTD = false;
#endif
        if constexpr (I8U_ON && K == 9 && L + 1 < DEPTH) { pg8::EpiRes<false, 0, 2, WTD> E{DRY ? 0.f : 0.5f}; pg8::gemm_phase<true>(F.lds, F.tid, F.wave, g, S, E); }
        else if constexpr (K == 9) { pg8::EpiRes<false, 0, 0, WTD> E{DRY ? 0.f : 0.5f}; pg8::gemm_phase<true>(F.lds, F.tid, F.wave, g, S, E); }
        else { pg8::EpiRes<false, 0, 0> E{DRY ? 0.f : 0.5f}; pg8::gemm_phase<true>(F.lds, F.tid, F.wave, g, S, E); }
    } else if constexpr (K == 2) {
        pg8::Gemm g{(bf16*)(ws_ + WS_XB), (bf16*)(ws_ + WL + W_IN), D, D, D, 0, MP}; pg8::StaticOrder S; S.init(MP, D, D, Gd, bid);
        pg8::EpiIn E{}; pg8::gemm_phase<true>(F.lds, F.tid, F.wave, g, S, E);
    } else if constexpr (K == 3) { MIXER_M1(L) }
    else if constexpr (K == 4) { MIXER_M2(L) }
    else if constexpr (K == 5) { MIXER_M3(L) }
    else if constexpr (K == 6) {
        const int hg = Gd / 2;
        { pg8::Gemm g{(bf16*)(ws_ + WS_GB), (bf16*)(ws_ + WL + W_GLU), SW, SW, SW, 0, MP}; pg8::StaticOrder S; S.init(MP, SW, SW, hg, bid < hg ? bid : -1);
          pg8::EpiMix<0> E{L}; pg8::gemm_phase<true>(F.lds, F.tid, F.wave, g, S, E); }
        { pg8::Gemm g{(bf16*)(ws_ + WS_PRE), (bf16*)(ws_ + WL + W_POOL), 256, PW, 256, 256, MP}; pg8::StaticOrder S; S.init(MP, PW, 256, Gd - hg, bid >= hg ? bid - hg : -1);
          pg8::EpiMix<1> E{L}; pg8::gemm_phase<true>(F.lds, wid0 * 64 + pg8::fresh_lane(), F.wave, g, S, E); }
    } else if constexpr (K == 7) {
        pg8::Gemm g{(bf16*)(ws_ + WS_MC), (bf16*)(ws_ + WL + W_OUT), D, D, D, 0, MP}; pg8::StaticOrder S; S.init(MP, D, D, Gd, bid);
#if defined(RES_WT)
        constexpr int QX = I8U_ON ? 1 : 0; pg8::EpiRes<true, 8, QX, true> E{DRY ? 0.f : 1.f}; pg8::gemm_phase<true>(F.lds, F.tid, F.wave, g, S, E);
#else
        constexpr int QX = I8U_ON ? 1 : 0; pg8::EpiRes<true, 8, QX> E{DRY ? 0.f : 1.f}; pg8::gemm_phase<true>(F.lds, F.tid, F.wave, g, S, E);
#endif
    }
}
#ifndef PROBE_DUP
#define PROBE_DUP -1
#endif
#define GRID_BAR() xcd_barrier_fn((unsigned*)(kargs().ws + WS_CTL), xb_xcc_id(), MISC + 8)
#if defined(XL_SEAMS)
__device__ __forceinline__ int own_panel_n1024() { pg8::StaticOrder S; S.init(MP, D, D, gridDim.x, blockIdx.x); return S.next(0).pm; }
__device__ __forceinline__ int own_panel_gp() { const int hg = gridDim.x / 2, b = blockIdx.x; pg8::StaticOrder S; if (b < hg) S.init(MP, SW, SW, hg, b); else S.init(MP, PW, 256, (int)gridDim.x - hg, b - hg); return S.next(0).pm; }
#if defined(XP_SEAMS)
#define SEAM_BAR(K) do { if (((K) == 1 || (K) == 6) && MISC[12] != 0u && gridDim.x == 256u) xp_barrier_fn((unsigned*)(kargs().ws + WS_CTL), (K) == 1 ? own_panel_n1024() : own_panel_gp(), own_panel_n1024(), MISC + 8); \
    else if (((K) == 2 || (K) == 5) && MISC[12] != 0u) xl_barrier_fn((unsigned*)(kargs().ws + WS_CTL), MISC + 8); else GRID_BAR(); } while (0)
#else
#define SEAM_BAR(K) do { if (((K) == 1 || (K) == 2 || (K) == 5 || (K) == 6) && MISC[12] != 0u) xl_barrier_fn((unsigned*)(kargs().ws + WS_CTL), MISC + 8); else GRID_BAR(); } while (0)
#endif
#else
#define SEAM_BAR(K) GRID_BAR()
#endif
constexpr int PH_PER_LAYER = 10, PH_FIN = 1 + 2 * PH_PER_LAYER, PH_TOTAL = PH_FIN + 1;
#define PHASE(ph, L, K) if (ph_lo <= (ph) && (ph) < ph_hi) { \
    if (PROBE_DUP == (K)) { run_phase<L, K, true>(lds_raw, wid0); GRID_BAR(); } \
    run_phase<L, K, false>(lds_raw, wid0); if ((ph) + 1 < ph_hi) SEAM_BAR(K); }
#define LAYER(L) PHASE(1 + 10 * L + 0, L, 0) PHASE(1 + 10 * L + 1, L, 1) PHASE(1 + 10 * L + 2, L, 2) PHASE(1 + 10 * L + 3, L, 3) PHASE(1 + 10 * L + 4, L, 4) \
                 PHASE(1 + 10 * L + 5, L, 5) PHASE(1 + 10 * L + 6, L, 6) PHASE(1 + 10 * L + 7, L, 7) PHASE(1 + 10 * L + 8, L, 8) PHASE(1 + 10 * L + 9, L, 9)

__global__ void __launch_bounds__(512, 2) mega(Args a_) {
    extern __shared__ __attribute__((aligned(16))) unsigned char lds_raw[];
    volatile LAS unsigned* MISC = (volatile LAS unsigned*)((LAS unsigned char*)lds_raw + LDSCTL_OFF);
    if (threadIdx.x < 64) MISC[threadIdx.x] = 0u;
    __syncthreads();
    const int ph_lo = a_.ph_lo, ph_hi = a_.ph_hi; const int wid0 = __builtin_amdgcn_readfirstlane(threadIdx.x >> 6);
    if (ph_hi - ph_lo > 1 || PROBE_DUP >= 0) (void)xcd_barrier_post((unsigned*)(a_.ws + WS_CTL), MISC + 8);
    if (threadIdx.x == 0) __hip_atomic_store((unsigned*)(a_.ws + WS_CTL) + XL_TAB + blockIdx.x, xb_xcc_id(), __ATOMIC_RELAXED, __HIP_MEMORY_SCOPE_AGENT);
#if defined(I8U)
#if defined(PROBE_WMAX2)
    if (ph_lo == 0) { run_phase<-1, 102, false>(lds_raw, wid0); GRID_BAR(); }
#endif
#if !defined(P0_FUSE)
    if (ph_lo == 0) { run_phase<-1, 102, false>(lds_raw, wid0); GRID_BAR(); }
#endif
#endif
    PHASE(0, -1, 100)
#if defined(XL_SEAMS)
    if (ph_lo == 0 && ph_hi > 1) xl_census((unsigned*)(kargs().ws + WS_CTL), MISC + 8);
#endif
#if defined(PROBE_NBAR)
    for (int i_ = 0; i_ < PROBE_NBAR; ++i_) GRID_BAR();
#endif
    LAYER(0)
    LAYER(1)
    PHASE(PH_FIN, -1, 101)
}
static void launch_mega(hipStream_t stream, const Args& base, int lo, int hi, int grid) {
    Args a = base; a.ph_lo = lo; a.ph_hi = hi;
#if !defined(PLAIN_LAUNCH)
    void* kargs_[] = {&a};
    hipError_t e = hipLaunchCooperativeKernel((const void*)mega, dim3(grid), dim3(512), kargs_, LDS_BYTES, stream);
    if (e != hipSuccess) fprintf(stderr, "kernel_launch: cooperative launch failed: %s (grid %d)\n", hipGetErrorString(e), grid);
#else
    hipLaunchKernelGGL(mega, dim3(grid), dim3(512), LDS_BYTES, stream, a);
#endif
}
extern "C" void kernel_launch(void* const* d_in, const int* in_sizes, int n_in, void* d_out, int out_size, void* d_ws, size_t ws_size, hipStream_t stream) {
    static int grid = 0;
    if (grid == 0) {
        if (n_in != 31 || ws_size < WS_END) { fprintf(stderr, "kernel_launch: unexpected n_in %d / ws_size %zu (need %zu)\n", n_in, ws_size, (size_t)WS_END); grid = -1; return; }
        int dev = 0, cus = 0, per_cu = 0;
        (void)hipGetDevice(&dev); (void)hipDeviceGetAttribute(&cus, hipDeviceAttributeMultiprocessorCount, dev);
        if (hipFuncSetAttribute((const void*)mega, hipFuncAttributeMaxDynamicSharedMemorySize, LDS_BYTES) != hipSuccess) { fprintf(stderr, "kernel_launch: hipFuncSetAttribute failed\n"); grid = -1; return; }
        if (hipOccupancyMaxActiveBlocksPerMultiprocessor(&per_cu, (const void*)mega, 512, LDS_BYTES) != hipSuccess || per_cu < 1) { fprintf(stderr, "kernel_launch: occupancy query says %d blocks/CU\n", per_cu); }
        (void)hipGetLastError();
        if (cus < 256 || per_cu < 1) { fprintf(stderr, "kernel_launch: built for a 256-CU device with >= 1 resident workgroup per CU (got %d CUs, %d per CU); nothing launched\n", cus, per_cu); grid = -1; return; }
        grid = 256;
    }
    if (grid < 0) return;
    (void)hipMemsetAsync((char*)d_ws + WS_CTL, 0, CTL_ZERO_BYTES, stream);
    Args a{}; for (int i = 0; i < 31; ++i) a.in[i] = (const float*)d_in[i];
    a.out = (float*)d_out; a.ws = (unsigned char*)d_ws;
#if defined(MK_PER_PHASE)
    for (int ph = 0; ph < PH_TOTAL; ++ph) launch_mega(stream, a, ph, ph + 1, grid);
#else
    launch_mega(stream, a, 0, PH_TOTAL, grid);
#endif
}
```
